# Optimizing an MI355X kernel written in HIP

```python
import math
import jax, jax.numpy as jnp
from jax import lax
import numpy as np

D_MODEL = 1024
BATCH = 1
SEQ = 16384
DEPTH = 1

N_HEADS = 8
HEAD_DIM = 64
N_KV = 2
HPG = N_HEADS // N_KV
ATTN_WIDTH = N_HEADS * HEAD_DIM
SSM_GROUP = 16
SSM_GROUPS = 32
SSM_WIDTH = SSM_GROUP * SSM_GROUPS
SSM_STATE = 64
MIX_WIDTH = ATTN_WIDTH + SSM_WIDTH
KV_WIDTH = N_KV * HEAD_DIM
IN_WIDTH = ATTN_WIDTH + 6 * KV_WIDTH + 3 * N_HEADS + SSM_WIDTH
CMP_LEN = 32
CMP_STRIDE = 16
CMP_HIDDEN = 128
SEL_BLOCK = 64
N_SEL = 16
WINDOW = 512
Q_BLOCK = 128
ROPE_THETA = 500000.0
ROPE_DIM = HEAD_DIM // 4
PEER_HEADS = 8
PEER_NKEYS = 128
PEER_EXPERTS = PEER_NKEYS * PEER_NKEYS
PEER_QDIM = 256
PEER_TOPK = 16
PEER_CHUNK = 128
NORM_EPS = 1e-6
NEG_INF = -1e30
FORCE_SCORE = 1e9

kernel_name = "hymba_nsa_s5_peer_block"


def rms_norm(x, g):
    xf = x.astype(jnp.float32)
    y = xf * lax.rsqrt(jnp.mean(xf * xf, axis=-1, keepdims=True) + NORM_EPS)
    return (y * g.astype(jnp.float32)).astype(x.dtype)


def rope(x, pos):
    half = ROPE_DIM // 2
    inv = ROPE_THETA ** (-jnp.arange(half, dtype=jnp.float32) * 2.0 / ROPE_DIM)
    ang = pos.astype(jnp.float32)[:, None] * inv[None, :]
    cos = jnp.cos(ang)[None, :, None, :]
    sin = jnp.sin(ang)[None, :, None, :]
    xr = x[..., :ROPE_DIM].astype(jnp.float32)
    x1, x2 = xr[..., :half], xr[..., half:]
    rot = jnp.concatenate([x1 * cos - x2 * sin, x2 * cos + x1 * sin], axis=-1).astype(x.dtype)
    return jnp.concatenate([rot, x[..., ROPE_DIM:]], axis=-1)


def masked_softmax(s, mask):
    s = jnp.where(mask, s, NEG_INF)
    m = jnp.max(s, axis=-1, keepdims=True)
    e = jnp.where(mask, jnp.exp(s - m), 0.0)
    return e / jnp.maximum(jnp.sum(e, axis=-1, keepdims=True), 1e-30)


def compress(kv, pe, w1, w2):
    b, s = kv.shape[0], kv.shape[1]
    n_cmp = (s - CMP_LEN) // CMP_STRIDE + 1
    idx = jnp.arange(n_cmp)[:, None] * CMP_STRIDE + jnp.arange(CMP_LEN)[None, :]
    blk = kv[:, idx] + pe[None, None, :, None, :]
    blk = blk.transpose(0, 1, 3, 2, 4).reshape(b, n_cmp, N_KV, CMP_LEN * HEAD_DIM)
    return jax.nn.gelu(blk @ w1) @ w2


def nsa_attention(q, kc_raw, vc_raw, ks, vs, kw, vw, gates, pe_k, w1k, w2k, pe_v, w1v, w2v):
    b, s = q.shape[0], q.shape[1]
    pos = jnp.arange(s)
    n_blk = s // Q_BLOCK
    n_selb = s // SEL_BLOCK
    n_sel = min(N_SEL, n_selb)
    q = rope(q, pos) * (HEAD_DIM ** -0.5)
    kc = compress(kc_raw, pe_k, w1k, w2k)
    vc = compress(vc_raw, pe_v, w1v, w2v)
    n_cmp = kc.shape[1]
    cmp_start = jnp.arange(n_cmp) * CMP_STRIDE
    cmp_end = cmp_start + CMP_LEN - 1
    kc = rope(kc, cmp_end).transpose(0, 2, 1, 3)
    vc = vc.transpose(0, 2, 1, 3)
    sel_ids = jnp.arange(n_selb)
    sel_start = sel_ids * SEL_BLOCK
    overlap = ((cmp_start[:, None] < sel_start[None, :] + SEL_BLOCK)
               & (cmp_start[:, None] + CMP_LEN > sel_start[None, :])).astype(jnp.float32)
    ks_blk = rope(ks, pos).reshape(b, n_selb, SEL_BLOCK, N_KV, HEAD_DIM).transpose(0, 3, 1, 2, 4)
    vs_blk = vs.reshape(b, n_selb, SEL_BLOCK, N_KV, HEAD_DIM).transpose(0, 3, 1, 2, 4)
    kw_pad = jnp.pad(rope(kw, pos), ((0, 0), (WINDOW, 0), (0, 0), (0, 0))).transpose(0, 2, 1, 3)
    vw_pad = jnp.pad(vw, ((0, 0), (WINDOW, 0), (0, 0), (0, 0))).transpose(0, 2, 1, 3)
    q_blocks = q.reshape(b, n_blk, Q_BLOCK, N_KV, HPG, HEAD_DIM).transpose(1, 0, 3, 4, 2, 5)
    g_blocks = jax.nn.sigmoid(gates.astype(jnp.float32)).reshape(
        b, n_blk, Q_BLOCK, N_KV, HPG, 3).transpose(1, 0, 3, 4, 2, 5)
    b_ix = jnp.arange(b)[:, None, None, None]
    g_ix = jnp.arange(N_KV)[None, :, None, None]

    def block(args):
        blk, qb, gb = args
        t = blk * Q_BLOCK + jnp.arange(Q_BLOCK)
        s_c = jnp.einsum('bghqd,bgnd->bghqn', qb, kc).astype(jnp.float32)
        p_c = masked_softmax(s_c, cmp_end[None, :] <= t[:, None])
        o_c = jnp.einsum('bghqn,bgnd->bghqd', p_c.astype(vc.dtype), vc)
        imp = jnp.einsum('bghqn,nm->bgqm', p_c, overlap)
        cur = (t // SEL_BLOCK)[:, None]
        valid = sel_start[None, :] <= t[:, None]
        forced = (sel_ids[None, :] == 0) | (sel_ids[None, :] == cur) | (sel_ids[None, :] == cur - 1)
        imp = jnp.where(forced, FORCE_SCORE, jnp.where(valid, imp, NEG_INF))
        _, sidx = lax.top_k(imp, n_sel)
        k_sel = ks_blk[b_ix, g_ix, sidx]
        v_sel = vs_blk[b_ix, g_ix, sidx]
        s_s = jnp.einsum('bghqd,bgqnkd->bghqnk', qb, k_sel).astype(jnp.float32)
        kpos = sidx[..., None] * SEL_BLOCK + jnp.arange(SEL_BLOCK)
        m_s = (kpos <= t[:, None, None])[:, :, None]
        shp = s_s.shape
        p_s = masked_softmax(s_s.reshape(shp[0], shp[1], shp[2], shp[3], -1),
                             m_s.reshape(shp[0], shp[1], 1, shp[3], -1)).reshape(shp)
        o_s = jnp.einsum('bghqnk,bgqnkd->bghqd', p_s.astype(v_sel.dtype), v_sel)
        start = blk * Q_BLOCK
        k_w = lax.dynamic_slice_in_dim(kw_pad, start, Q_BLOCK + WINDOW, axis=2)
        v_w = lax.dynamic_slice_in_dim(vw_pad, start, Q_BLOCK + WINDOW, axis=2)
        kpos_w = start - WINDOW + jnp.arange(Q_BLOCK + WINDOW)
        m_w = ((kpos_w[None, :] >= 0) & (kpos_w[None, :] <= t[:, None])
               & (t[:, None] - kpos_w[None, :] < WINDOW))
        s_w = jnp.einsum('bghqd,bgkd->bghqk', qb, k_w).astype(jnp.float32)
        p_w = masked_softmax(s_w, m_w)
        o_w = jnp.einsum('bghqk,bgkd->bghqd', p_w.astype(v_w.dtype), v_w)
        gb = gb.astype(qb.dtype)
        return gb[..., 0:1] * o_c + gb[..., 1:2] * o_s + gb[..., 2:3] * o_w

    out = lax.map(block, (jnp.arange(n_blk), q_blocks, g_blocks))
    return out.transpose(1, 0, 4, 2, 3, 5).reshape(b, s, ATTN_WIDTH)


def s5_ssm(u, lam_re, lam_im, log_dt, b_re, b_im, c_re, c_im, d_skip, w_glu):
    b, s = u.shape[0], u.shape[1]
    f32 = jnp.float32
    lam = lax.complex(lam_re.astype(f32), lam_im.astype(f32))
    dt = jnp.exp(log_dt.astype(f32))[:, None]
    lam_bar = jnp.exp(lam * dt)
    bmat = lax.complex(b_re.astype(f32), b_im.astype(f32))
    b_bar = ((lam_bar - 1.0) / lam)[..., None] * bmat
    cmat = lax.complex(c_re.astype(f32), c_im.astype(f32))
    uf = u.astype(f32)
    ug = uf.reshape(b, s, SSM_GROUPS, SSM_GROUP).astype(jnp.complex64)
    bu = jnp.einsum('gpc,bsgc->bsgp', b_bar, ug)
    a = jnp.broadcast_to(lam_bar, bu.shape)

    def combine(e1, e2):
        a1, b1 = e1
        a2, b2 = e2
        return (a1 * a2, a2 * b1 + b2)

    _, states = lax.associative_scan(combine, (a, bu), axis=1)
    y = jnp.real(jnp.einsum('gcp,bsgp->bsgc', cmat, states)).reshape(b, s, SSM_WIDTH)
    y = jax.nn.gelu(y + d_skip.astype(f32) * uf).astype(u.dtype)
    ab = y @ w_glu
    return ab[..., :SSM_WIDTH] * jax.nn.sigmoid(ab[..., SSM_WIDTH:])


def peer_ffn(x, w_q, sub1, sub2, u_tab, v_tab):
    b, s, d = x.shape
    n_ch = s // PEER_CHUNK
    half = PEER_QDIM // 2
    xc = x.reshape(b, n_ch, PEER_CHUNK, d).transpose(1, 0, 2, 3)

    def chunk(xb):
        q = (xb @ w_q).reshape(b, PEER_CHUNK, PEER_HEADS, PEER_QDIM)
        s1 = jnp.einsum('bchd,kd->bchk', q[..., :half], sub1).astype(jnp.float32)
        s2 = jnp.einsum('bchd,kd->bchk', q[..., half:], sub2).astype(jnp.float32)
        v1, i1 = lax.top_k(s1, PEER_TOPK)
        v2, i2 = lax.top_k(s2, PEER_TOPK)
        cand = (v1[..., :, None] + v2[..., None, :]).reshape(b, PEER_CHUNK, PEER_HEADS, PEER_TOPK * PEER_TOPK)
        cidx = (i1[..., :, None] * PEER_NKEYS + i2[..., None, :]).reshape(b, PEER_CHUNK, PEER_HEADS, PEER_TOPK * PEER_TOPK)
        top, sel = lax.top_k(cand, PEER_TOPK)
        eidx = jnp.take_along_axis(cidx, sel, axis=-1)
        gate = jax.nn.softmax(top, axis=-1)
        u_sel = u_tab[eidx]
        v_sel = v_tab[eidx]
        hid = jnp.einsum('bcd,bchkd->bchk', xb, u_sel).astype(jnp.float32)
        act = (jax.nn.gelu(hid) * gate).astype(xb.dtype)
        return jnp.einsum('bchk,bchkd->bcd', act, v_sel)

    out = lax.map(chunk, xc)
    return out.transpose(1, 0, 2, 3).reshape(b, s, d)


def setup_inputs(seed: int = 0) -> dict:
    key = jax.random.key(seed)
    ks = jax.random.split(key, 25)
    f32 = jnp.float32

    def nrm(k, shape, scale):
        return jax.random.normal(k, shape, f32) * scale

    return {
        'x': nrm(ks[0], (BATCH, SEQ, D_MODEL), 1.0),
        'attn_norm': 1.0 + nrm(ks[1], (DEPTH, D_MODEL), 0.01),
        'w_in': nrm(ks[2], (DEPTH, D_MODEL, IN_WIDTH), D_MODEL ** -0.5),
        'cmp_k_pe': nrm(ks[3], (DEPTH, CMP_LEN, HEAD_DIM), 0.1),
        'cmp_k_w1': nrm(ks[4], (DEPTH, CMP_LEN * HEAD_DIM, CMP_HIDDEN), (CMP_LEN * HEAD_DIM) ** -0.5),
        'cmp_k_w2': nrm(ks[5], (DEPTH, CMP_HIDDEN, HEAD_DIM), CMP_HIDDEN ** -0.5),
        'cmp_v_pe': nrm(ks[6], (DEPTH, CMP_LEN, HEAD_DIM), 0.1),
        'cmp_v_w1': nrm(ks[7], (DEPTH, CMP_LEN * HEAD_DIM, CMP_HIDDEN), (CMP_LEN * HEAD_DIM) ** -0.5),
        'cmp_v_w2': nrm(ks[8], (DEPTH, CMP_HIDDEN, HEAD_DIM), CMP_HIDDEN ** -0.5),
        'ssm_lam_re': -0.5 + nrm(ks[9], (DEPTH, SSM_GROUPS, SSM_STATE), 0.01),
        'ssm_lam_im': jnp.broadcast_to(math.pi * jnp.arange(SSM_STATE, dtype=f32), (DEPTH, SSM_GROUPS, SSM_STATE)),
        'ssm_log_dt': jax.random.uniform(ks[10], (DEPTH, SSM_GROUPS), f32, math.log(1e-3), math.log(1e-1)),
        'ssm_b_re': nrm(ks[11], (DEPTH, SSM_GROUPS, SSM_STATE, SSM_GROUP), (2 * SSM_GROUP) ** -0.5),
        'ssm_b_im': nrm(ks[12], (DEPTH, SSM_GROUPS, SSM_STATE, SSM_GROUP), (2 * SSM_GROUP) ** -0.5),
        'ssm_c_re': nrm(ks[13], (DEPTH, SSM_GROUPS, SSM_GROUP, SSM_STATE), 0.5),
        'ssm_c_im': nrm(ks[14], (DEPTH, SSM_GROUPS, SSM_GROUP, SSM_STATE), 0.5),
        'ssm_d': nrm(ks[15], (DEPTH, SSM_WIDTH), 1.0),
        'ssm_w_glu': nrm(ks[16], (DEPTH, SSM_WIDTH, 2 * SSM_WIDTH), SSM_WIDTH ** -0.5),
        'w_out': nrm(ks[17], (DEPTH, MIX_WIDTH, D_MODEL), MIX_WIDTH ** -0.5),
        'ffn_norm': 1.0 + nrm(ks[18], (DEPTH, D_MODEL), 0.01),
        'peer_w_q': nrm(ks[19], (DEPTH, D_MODEL, PEER_HEADS * PEER_QDIM), D_MODEL ** -0.5),
        'peer_subkeys_1': nrm(ks[20], (DEPTH, PEER_NKEYS, PEER_QDIM // 2), (PEER_QDIM // 2) ** -0.5),
        'peer_subkeys_2': nrm(ks[21], (DEPTH, PEER_NKEYS, PEER_QDIM // 2), (PEER_QDIM // 2) ** -0.5),
        'peer_u': nrm(ks[22], (DEPTH, PEER_EXPERTS, D_MODEL), D_MODEL ** -0.5),
        'peer_v': nrm(ks[23], (DEPTH, PEER_EXPERTS, D_MODEL), PEER_HEADS ** -0.5),
        'final_norm': 1.0 + nrm(ks[24], (D_MODEL,), 0.01),
    }


def reference(x, attn_norm, w_in, cmp_k_pe, cmp_k_w1, cmp_k_w2, cmp_v_pe, cmp_v_w1, cmp_v_w2,
              ssm_lam_re, ssm_lam_im, ssm_log_dt, ssm_b_re, ssm_b_im, ssm_c_re, ssm_c_im, ssm_d,
              ssm_w_glu, w_out, ffn_norm, peer_w_q, peer_subkeys_1, peer_subkeys_2, peer_u, peer_v,
              final_norm):
    b, s, _ = x.shape
    sizes = [ATTN_WIDTH] + [KV_WIDTH] * 6 + [3 * N_HEADS]
    cuts = [int(c) for c in np.cumsum(sizes)]
    h = x
    for l in range(DEPTH):
        z = rms_norm(h, attn_norm[l])
        proj = z @ w_in[l]
        q, kc, vc, ksl, vsl, kwn, vwn, gates, u = jnp.split(proj, cuts, axis=-1)
        kv_shape = (b, s, N_KV, HEAD_DIM)
        a_out = nsa_attention(q.reshape(b, s, N_HEADS, HEAD_DIM),
                              kc.reshape(kv_shape), vc.reshape(kv_shape),
                              ksl.reshape(kv_shape), vsl.reshape(kv_shape),
                              kwn.reshape(kv_shape), vwn.reshape(kv_shape), gates,
                              cmp_k_pe[l], cmp_k_w1[l], cmp_k_w2[l],
                              cmp_v_pe[l], cmp_v_w1[l], cmp_v_w2[l])
        s_out = s5_ssm(u, ssm_lam_re[l], ssm_lam_im[l], ssm_log_dt[l], ssm_b_re[l], ssm_b_im[l],
                       ssm_c_re[l], ssm_c_im[l], ssm_d[l], ssm_w_glu[l])
        h = h + jnp.concatenate([a_out, s_out], axis=-1) @ w_out[l]
        h = h + peer_ffn(rms_norm(h, ffn_norm[l]), peer_w_q[l], peer_subkeys_1[l],
                         peer_subkeys_2[l], peer_u[l], peer_v[l])
    return rms_norm(h, final_norm)
```

```cpp
#include <hip/hip_runtime.h>
#include <hip/hip_cooperative_groups.h>
#include <cstdio>
#include <cstdint>
#include <type_traits>
namespace cg = cooperative_groups;

#define LAS __attribute__((address_space(3)))
typedef unsigned short bf16_t;
using bf16x8 = __attribute__((ext_vector_type(8))) short;
using f32x4 = __attribute__((ext_vector_type(4))) float;
using u32x4 = __attribute__((ext_vector_type(4))) unsigned int;

#define SEQ 16384
#define DMODEL 1024
#define NEG_INF_F (-1e30f)
#define NPHASE 10
#define SMEM_BYTES 79872

#define MB (1024ull * 1024ull)
#define OFF_UT (0ull)
#define OFF_VT (32 * MB)
#define OFF_W (64 * MB)
#define OFF_WIN (OFF_W)
#define OFF_WGLU (OFF_WIN + 3932160ull)
#define OFF_WOUT (OFF_WGLU + 1048576ull)
#define OFF_WQ (OFF_WOUT + 2097152ull)
#define OFF_W1K (OFF_WQ + 4194304ull)
#define OFF_W1V (OFF_W1K + 524288ull)
#define OFF_W2K (OFF_W1V + 524288ull)
#define OFF_W2V (OFF_W2K + 16384ull)
#define OFF_BIASK (OFF_W2V + 16384ull)
#define OFF_BIASV (OFF_BIASK + 512ull)
#define OFF_SUBT (OFF_BIASV + 512ull)
#define OFF_LAMB (OFF_SUBT + 65536ull)
#define OFF_LAM64 (OFF_LAMB + 16384ull)
#define OFF_BBAR (OFF_LAM64 + 16384ull)
#define OFF_Z (80 * MB)
#define OFF_Q (112 * MB)
#define OFF_KV (128 * MB)
#define KV_STRIDE (4 * MB)
#define OFF_U (152 * MB)
#define OFF_MIX (184 * MB)
#define OFF_GATES (216 * MB)
#define OFF_KC (OFF_GATES + 1572864ull)
#define OFF_VC (OFF_KC + 262144ull)
#define OFF_HID (218 * MB)
#define OFF_E (219 * MB)
#define OFF_CIN (223 * MB)
#define OFF_YG (227 * MB)
#define OFF_WQB (OFF_YG)
#define OFF_SM (OFF_MIX)
#define OFF_SQ (OFF_MIX + 24 * MB)
#define OFF_CINB (OFF_CIN)
#define OFF_KT (OFF_CIN + 2 * MB)
#define OFF_UB (OFF_MIX + 8 * MB)
#define OFF_SSQ OFF_E
#define OFF_PQ (112 * MB)

struct Params {
  const float* in[26];
  float* out;
  char* ws;
};

__device__ __forceinline__ int get_tid() {
  int t = threadIdx.x;
  asm volatile("" : "+v"(t));
  return t;
}
__device__ __forceinline__ bf16_t f2bf(float f) {
  unsigned u = __float_as_uint(f);
  u += 0x7FFFu + ((u >> 16) & 1u);
  return (bf16_t)(u >> 16);
}
__device__ __forceinline__ float bf2f(bf16_t b) { return __uint_as_float(((unsigned)b) << 16); }
__device__ __forceinline__ float bflo(unsigned w) { return __uint_as_float(w << 16); }
__device__ __forceinline__ float bfhi(unsigned w) { return __uint_as_float(w & 0xFFFF0000u); }
typedef __bf16 bf16v2_t __attribute__((ext_vector_type(2)));
typedef float f32v2_t __attribute__((ext_vector_type(2)));
__device__ __forceinline__ unsigned pack2(float a, float b) {
  f32v2_t v = {a, b};
  return __builtin_bit_cast(unsigned, __builtin_convertvector(v, bf16v2_t));
}

__device__ __forceinline__ float gelu_tanh(float x) {
  const float u2 = 2.f * 0.7978845608028654f * (x + 0.044715f * x * x * x);
  return x * __builtin_amdgcn_rcpf(1.f + __builtin_amdgcn_exp2f(-1.4426950408889634f * u2));
}
__device__ __forceinline__ float sigmoid_f(float x) { return __builtin_amdgcn_rcpf(1.f + __builtin_amdgcn_exp2f(-1.4426950408889634f * x)); }

__device__ __forceinline__ float wave_sum(float v) {
#pragma unroll
  for (int o = 32; o > 0; o >>= 1) v += __shfl_xor(v, o, 64);
  return v;
}
__device__ __forceinline__ float wave_max(float v) {
#pragma unroll
  for (int o = 32; o > 0; o >>= 1) v = fmaxf(v, __shfl_xor(v, o, 64));
  return v;
}
__device__ __forceinline__ void wave_argmax(float& v, int& i) {
#pragma unroll
  for (int o = 32; o > 0; o >>= 1) {
    float ov = __shfl_xor(v, o, 64);
    int oi = __shfl_xor(i, o, 64);
    if (ov > v || (ov == v && oi < i)) { v = ov; i = oi; }
  }
}
__device__ __forceinline__ void wave_lds_sync() { asm volatile("s_waitcnt lgkmcnt(0)" ::: "memory"); }

__device__ __forceinline__ void sincos_big(float ang, float& sn, float& cs) {
  double rev = (double)ang * 0.15915494309189535;
  rev -= floor(rev);
  float fr = (float)rev;
  sn = __builtin_amdgcn_sinf(fr);
  cs = __builtin_amdgcn_cosf(fr);
}
__device__ __forceinline__ float rope_inv(int i) {
  return exp2f(-(float)i * 2.36644607f);
}

template <int BMODE = 0, bool ZERO = true>
__device__ __forceinline__ void gemm_tile_128(const bf16_t* __restrict__ A, long lda, int M,
                                              const bf16_t* __restrict__ Bt, long ldb, int N, int K,
                                              int row0, int col0, char* smem, f32x4 (&acc)[4][4]) {
  bf16_t(*sA)[72] = (bf16_t(*)[72])smem;
  bf16_t(*sB)[72] = (bf16_t(*)[72])(smem + 128 * 72 * 2);
  const int tid = get_tid(), lane = tid & 63, wid = tid >> 6;
  const int wr = wid >> 1, wc = wid & 1;
  if (ZERO) {
#pragma unroll
    for (int i = 0; i < 4; i++)
#pragma unroll
      for (int j = 0; j < 4; j++) acc[i][j] = (f32x4){0.f, 0.f, 0.f, 0.f};
  }
  const int lr = tid >> 3;
  const int lc = (tid & 7) * 8;
  u32x4 ra[4], rb[4];
  const u32x4 z4 = {0u, 0u, 0u, 0u};
  const bf16_t* pa[4];
  const bf16_t* pb[4];
  bool va[4], vb[4];
  int klim[4];
#pragma unroll
  for (int i = 0; i < 4; i++) {
    int r = lr + 32 * i;
    va[i] = (row0 + r < M);
    vb[i] = (col0 + r < N);
    pa[i] = A + (long)min(row0 + r, M - 1) * lda + lc;
    if (BMODE == 0) {
      pb[i] = Bt + (long)min(col0 + r, N - 1) * ldb + lc;
      klim[i] = 0;
    } else {
      const int n = col0 + r, t = n >> 4, ch = n & 15;
      pb[i] = Bt + ((long)(t - (lc >> 4)) * 16 + ch) * 16 + (lc & 15);
      klim[i] = (t + 1) * 16 - lc;
    }
  }
  u32x4 rc[4], rd[4];
  auto gload = [&](u32x4 (&xa)[4], u32x4 (&xb)[4], int k) __attribute__((always_inline)) {
#pragma unroll
    for (int i = 0; i < 4; i++) {
      u32x4 x = *(const u32x4*)(pa[i] + k);
      xa[i] = va[i] ? x : z4;
      if (BMODE == 0) {
        u32x4 y = *(const u32x4*)(pb[i] + k);
        xb[i] = vb[i] ? y : z4;
      } else {
        const bool ok = k < klim[i];
        u32x4 y = *(const u32x4*)(ok ? pb[i] - 16 * (long)k : Bt);
        xb[i] = ok ? y : z4;
      }
    }
  };
  auto lstore = [&](const u32x4 (&xa)[4], const u32x4 (&xb)[4], int buf) __attribute__((always_inline)) {
    bf16_t(*nA)[72] = (bf16_t(*)[72])(smem + buf * 36864);
    bf16_t(*nB)[72] = (bf16_t(*)[72])(smem + buf * 36864 + 18432);
#pragma unroll
    for (int i = 0; i < 4; i++) {
      int r = lr + 32 * i;
      *(u32x4*)&nA[r][lc] = xa[i];
      *(u32x4*)&nB[r][lc] = xb[i];
    }
  };
  auto compute = [&](int buf) __attribute__((always_inline)) {
    bf16_t(*cA)[72] = (bf16_t(*)[72])(smem + buf * 36864);
    bf16_t(*cB)[72] = (bf16_t(*)[72])(smem + buf * 36864 + 18432);
#pragma unroll
    for (int ks = 0; ks < 2; ks++) {
      bf16x8 af[4], bfr[4];
#pragma unroll
      for (int i = 0; i < 4; i++) af[i] = *(const bf16x8*)&cA[wr * 64 + i * 16 + (lane & 15)][ks * 32 + (lane >> 4) * 8];
#pragma unroll
      for (int j = 0; j < 4; j++) bfr[j] = *(const bf16x8*)&cB[wc * 64 + j * 16 + (lane & 15)][ks * 32 + (lane >> 4) * 8];
#pragma unroll
      for (int i = 0; i < 4; i++)
#pragma unroll
        for (int j = 0; j < 4; j++) acc[i][j] = __builtin_amdgcn_mfma_f32_16x16x32_bf16(af[i], bfr[j], acc[i][j], 0, 0, 0);
    }
  };
  gload(ra, rb, 0);
  if (64 < K) gload(rc, rd, 64);
  __syncthreads();
  lstore(ra, rb, 0);
  if (128 < K) gload(ra, rb, 128);
  for (int k0 = 0; k0 < K; k0 += 128) {
    __syncthreads();
    if (k0 + 64 < K) lstore(rc, rd, 1);
    if (k0 + 192 < K) gload(rc, rd, k0 + 192);
    compute(0);
    if (k0 + 64 < K) {
      __syncthreads();
      if (k0 + 128 < K) lstore(ra, rb, 0);
      if (k0 + 256 < K) gload(ra, rb, k0 + 256);
      compute(1);
    }
  }
  __syncthreads();
}

#define EPI_LD 68
__device__ __forceinline__ float* stage_acc(const f32x4 (&acc)[4][4], char* smem) {
  const int lane = get_tid() & 63, wid = get_tid() >> 6;
  float* t = (float*)(smem + wid * (64 * EPI_LD * 4));
  const int q = lane >> 4, c = lane & 15;
#pragma unroll
  for (int i = 0; i < 4; i++)
#pragma unroll
    for (int j = 0; j < 4; j++)
#pragma unroll
      for (int jj = 0; jj < 4; jj++) t[(i * 16 + q * 4 + jj) * EPI_LD + j * 16 + c] = acc[i][j][jj];
  wave_lds_sync();
  return t;
}

__device__ __forceinline__ void transpose_job(const float* __restrict__ src, int Ksrc, int Nsrc, bf16_t* __restrict__ dst, int Ndst,
                              int perm, int tile, char* smem) {
  float(*t)[65] = (float(*)[65])smem;
  const int tiles_k = Ksrc / 64;
  const int tn = tile / tiles_k, tk = tile % tiles_k;
  const int tid = get_tid();
  __syncthreads();
  for (int e = tid; e < 64 * 64; e += 256) {
    int kk = e >> 6, nn = e & 63;
    int n = tn * 64 + nn;
    int oc;
    if (perm == 1) {
      oc = (n < 1280) ? n : (n < 1792 ? 1304 + (n - 1280) : (n < 1816 ? 1280 + (n - 1792) : -1));
    } else if (perm == 2) {
      int b64 = n >> 6, w = n & 63;
      oc = (w < 32) ? (32 * b64 + w) : (512 + 32 * b64 + (w - 32));
    } else {
      oc = (n < Nsrc) ? n : -1;
    }
    float v = 0.f;
    if (oc >= 0) v = src[(size_t)(tk * 64 + kk) * Nsrc + oc];
    t[kk][nn] = v;
  }
  __syncthreads();
  for (int e = tid; e < 64 * 64; e += 256) {
    int nn = e >> 6, kk = e & 63;
    dst[(size_t)(tn * 64 + nn) * Ksrc + tk * 64 + kk] = f2bf(t[kk][nn]);
  }
}

__device__ __forceinline__ void phase0(const Params& p, char* smem) {
  const int tid = get_tid(), lane = tid & 63, wid = tid >> 6;
  const int gw = blockIdx.x * 4 + wid, nw = gridDim.x * 4;
  char* ws = p.ws;
  {
    const float* x = p.in[0];
    const float* g = p.in[1];
    bf16_t* z = (bf16_t*)(ws + OFF_Z);
    for (int r = gw; r < SEQ; r += nw) {
      const float4* src = (const float4*)(x + (size_t)r * 1024);
      float4 v[4];
      float ss = 0.f;
#pragma unroll
      for (int i = 0; i < 4; i++) {
        v[i] = src[lane + 64 * i];
        ss += v[i].x * v[i].x + v[i].y * v[i].y + v[i].z * v[i].z + v[i].w * v[i].w;
      }
      ss = wave_sum(ss);
      float inv = rsqrtf(ss * (1.f / 1024.f) + 1e-6f);
#pragma unroll
      for (int i = 0; i < 4; i++) {
        float4 gg = ((const float4*)g)[lane + 64 * i];
        uint2 o;
        o.x = pack2(v[i].x * inv * gg.x, v[i].y * inv * gg.y);
        o.y = pack2(v[i].z * inv * gg.z, v[i].w * inv * gg.w);
        *(uint2*)(z + (size_t)r * 1024 + (lane + 64 * i) * 4) = o;
      }
    }
  }
  {
    for (int j = blockIdx.x; j < 480; j += gridDim.x) transpose_job(p.in[2], 1024, 1816, (bf16_t*)(ws + OFF_WIN), 1920, 1, j, smem);
  }
  {
    const float4* src = (const float4*)p.in[20];
    uint2* dst = (uint2*)(ws + OFF_WQB);
    for (int i = blockIdx.x * 256 + tid; i < 1024 * 2048 / 4; i += gridDim.x * 256) {
      const float4 v = src[i];
      dst[i] = make_uint2(pack2(v.x, v.y), pack2(v.z, v.w));
    }
  }
  {
    bf16_t* dst = (bf16_t*)(ws + OFF_SUBT);
    for (int i = blockIdx.x * 256 + tid; i < 2 * 16384; i += gridDim.x * 256) {
      float v = (i < 16384) ? p.in[21][i] : p.in[22][i - 16384];
      dst[i] = f2bf(v);
    }
  }
  {
    bf16_t* SM = (bf16_t*)(ws + OFF_SM);
    for (int idx = blockIdx.x * 256 + tid; idx < 2048 * 64; idx += gridDim.x * 256) {
      const int gs = idx >> 6, t = idx & 63, g = gs >> 6, sidx = gs & 63;
      const float dt = expf(p.in[11][g]);
      const float lr = p.in[9][gs], li = p.in[10][gs];
      const float ang = li * dt;
      float sn, cs;
      sincos_big(ang, sn, cs);
      const float em1 = expm1f(lr * dt);
      const float mag = em1 + 1.f;
      float sh, ch;
      sincos_big(0.5f * ang, sh, ch);
      const float a = em1 * cs - 2.f * sh * sh;
      const float b = mag * sn;
      const float den = lr * lr + li * li;
      const float cr = (a * lr + b * li) / den;
      const float ci = (b * lr - a * li) / den;
      const float pw = (float)(63 - t);
      float snp, csp;
      sincos_big(pw * ang, snp, csp);
      const float mp = expf(pw * lr * dt);
      const float fx = mp * (csp * cr - snp * ci), fy = mp * (csp * ci + snp * cr);
      const float* bre = p.in[12] + (size_t)gs * 16;
      const float* bim = p.in[13] + (size_t)gs * 16;
      unsigned wre[8], wim[8];
#pragma unroll
      for (int c = 0; c < 8; c++) {
        const float xr0 = bre[2 * c], xi0 = bim[2 * c], xr1 = bre[2 * c + 1], xi1 = bim[2 * c + 1];
        wre[c] = pack2(fx * xr0 - fy * xi0, fx * xr1 - fy * xi1);
        wim[c] = pack2(fx * xi0 + fy * xr0, fx * xi1 + fy * xr1);
      }
      bf16_t* dre = SM + ((size_t)(g * 128 + sidx)) * 1024 + t * 16;
      bf16_t* dim = dre + (size_t)64 * 1024;
      *(uint4*)dre = make_uint4(wre[0], wre[1], wre[2], wre[3]);
      *(uint4*)(dre + 8) = make_uint4(wre[4], wre[5], wre[6], wre[7]);
      *(uint4*)dim = make_uint4(wim[0], wim[1], wim[2], wim[3]);
      *(uint4*)(dim + 8) = make_uint4(wim[4], wim[5], wim[6], wim[7]);
    }
  }
  {
    for (int gt = (((int)blockIdx.x + (int)gridDim.x - (256 % (int)gridDim.x)) % (int)gridDim.x) * 256 + tid; gt < 2048; gt += (int)gridDim.x * 256) {
      const int g = gt >> 6;
      const float dt = expf(p.in[11][g]);
      const float lr = p.in[9][gt], li = p.in[10][gt];
      float sn64, cs64;
      sincos_big(64.f * li * dt, sn64, cs64);
      const float m64 = expf(64.f * lr * dt);
      ((float2*)(ws + OFF_LAM64))[gt] = make_float2(m64 * cs64, m64 * sn64);
    }
  }
}

__device__ __forceinline__ void side_jobs(const Params& p, char* smem, int b0, int nb) {
  const int tid = get_tid(), lane = tid & 63, wid = tid >> 6;
  char* ws = p.ws;
  for (int j = b0; j < 132; j += nb) {
    if (j < 64) transpose_job(p.in[4], 2048, 128, (bf16_t*)(ws + OFF_W1K), 128, 0, j, smem);
    else if (j < 128) transpose_job(p.in[7], 2048, 128, (bf16_t*)(ws + OFF_W1V), 128, 0, j - 64, smem);
    else if (j < 130) transpose_job(p.in[5], 128, 64, (bf16_t*)(ws + OFF_W2K), 64, 0, j - 128, smem);
    else transpose_job(p.in[8], 128, 64, (bf16_t*)(ws + OFF_W2V), 64, 0, j - 130, smem);
  }
  {
    for (int o8 = b0 * 4 + wid; o8 < 32; o8 += nb * 4) {
      const int kv = o8 >> 4, j0 = (o8 & 15) * 8;
      const float* pe = kv ? p.in[6] : p.in[3];
      const float* w1 = kv ? p.in[7] : p.in[4];
      float a[8];
#pragma unroll
      for (int c = 0; c < 8; c++) a[c] = 0.f;
      for (int i = lane; i < 2048; i += 64) {
        const float pv = pe[i];
        const float4 w0 = *(const float4*)(w1 + (size_t)i * 128 + j0), w4 = *(const float4*)(w1 + (size_t)i * 128 + j0 + 4);
        a[0] += pv * w0.x; a[1] += pv * w0.y; a[2] += pv * w0.z; a[3] += pv * w0.w;
        a[4] += pv * w4.x; a[5] += pv * w4.y; a[6] += pv * w4.z; a[7] += pv * w4.w;
      }
#pragma unroll
      for (int c = 0; c < 8; c++) a[c] = wave_sum(a[c]);
      if (lane == 0) {
        float* dst = (float*)(ws + (kv ? OFF_BIASV : OFF_BIASK)) + j0;
        *(float4*)dst = make_float4(a[0], a[1], a[2], a[3]);
        *(float4*)(dst + 4) = make_float4(a[4], a[5], a[6], a[7]);
      }
    }
  }
}

__device__ __forceinline__ void phase1(const Params& p, char* smem) {
  char* ws = p.ws;
  const bf16_t* Z = (const bf16_t*)(ws + OFF_Z);
  const bf16_t* W = (const bf16_t*)(ws + OFF_WIN);
  bf16_t* Q = (bf16_t*)(ws + OFF_Q);
  float* GATES = (float*)(ws + OFF_GATES);
  const int lane = get_tid() & 63, wid = get_tid() >> 6, wr = wid >> 1, wc = wid & 1;
  for (int tile = blockIdx.x; tile < 128 * 15; tile += gridDim.x) {
    const int tm = tile / 15, tn = tile % 15;
    f32x4 acc[4][4];
    gemm_tile_128(Z, 1024, SEQ, W, 1024, 1920, 1024, tm * 128, tn * 128, smem, acc);
    const int sp = tn * 2 + wc;
    const int prow0 = tm * 128 + wr * 64;
    if (sp == 14 || sp == 15) {
      unsigned char* dst = (unsigned char*)(ws + OFF_KV + 3 * KV_STRIDE);
      const int hd = sp - 14;
#pragma unroll
      for (int j = 0; j < 4; j++) {
        const int d = j * 16 + (lane & 15);
#pragma unroll
        for (int i = 0; i < 4; i++) {
          const int pos0 = prow0 + i * 16 + (lane >> 4) * 4;
          int w = __builtin_amdgcn_cvt_pk_fp8_f32(acc[i][j][0] * 8.f, acc[i][j][1] * 8.f, 0, false);
          w = __builtin_amdgcn_cvt_pk_fp8_f32(acc[i][j][2] * 8.f, acc[i][j][3] * 8.f, w, true);
          *(int*)(dst + (((size_t)hd * 256 + (pos0 >> 6)) * 64 + d) * 64 + (pos0 & 63)) = w;
        }
      }
    } else if (sp == 18 || sp == 19) {
      const int hd = sp - 18;
#pragma unroll
      for (int j = 0; j < 4; j++) {
        const int d = j * 16 + (lane & 15);
        bf16_t* dst = (bf16_t*)(ws + OFF_KV + 5 * KV_STRIDE) + ((size_t)hd * 64 + d) * SEQ;
#pragma unroll
        for (int i = 0; i < 4; i++) {
          const int pos0 = prow0 + i * 16 + (lane >> 4) * 4;
          uint2 w;
          w.x = pack2(acc[i][j][0], acc[i][j][1]);
          w.y = pack2(acc[i][j][2], acc[i][j][3]);
          *(uint2*)(dst + pos0) = w;
        }
      }
    }
    {
      const float* t = stage_acc(acc, smem);
      const int rs = lane >> 3, ch = lane & 7;
      const bool is_q = sp < 8;
      const bool ropes = is_q || sp == 12 || sp == 13 || sp == 16 || sp == 17;
      const bool rowsec = (sp <= 13) || sp == 16 || sp == 17 || (sp >= 20 && sp <= 28);
      if (rowsec) {
#pragma unroll 2
        for (int it = 0; it < 8; it++) {
          const int r = it * 8 + rs;
          const int pos = prow0 + r;
          const float* tr = t + r * EPI_LD + 8 * ch;
          float4 a0 = *(const float4*)tr, a1 = *(const float4*)(tr + 4);
          float v[8] = {a0.x, a0.y, a0.z, a0.w, a1.x, a1.y, a1.z, a1.w};
          if (ropes && ch < 2) {
            const float* tp = t + r * EPI_LD + 8 * (ch ^ 1);
            float4 b0 = *(const float4*)tp, b1 = *(const float4*)(tp + 4);
            const float pv[8] = {b0.x, b0.y, b0.z, b0.w, b1.x, b1.y, b1.z, b1.w};
            const float sgn = (ch == 0) ? -1.f : 1.f;
#pragma unroll
            for (int i = 0; i < 8; i++) {
              float sn, cs;
              sincos_big((float)pos * rope_inv(i), sn, cs);
              v[i] = v[i] * cs + sgn * pv[i] * sn;
            }
          }
          if (is_q) {
            uint4 w;
            w.x = pack2(v[0] * 0.125f, v[1] * 0.125f); w.y = pack2(v[2] * 0.125f, v[3] * 0.125f);
            w.z = pack2(v[4] * 0.125f, v[5] * 0.125f); w.w = pack2(v[6] * 0.125f, v[7] * 0.125f);
            *(uint4*)(Q + ((size_t)pos * 8 + sp) * 64 + 8 * ch) = w;
          } else if (sp == 12 || sp == 13) {
            int w0 = __builtin_amdgcn_cvt_pk_fp8_f32(v[0] * 8.f, v[1] * 8.f, 0, false);
            w0 = __builtin_amdgcn_cvt_pk_fp8_f32(v[2] * 8.f, v[3] * 8.f, w0, true);
            int w1 = __builtin_amdgcn_cvt_pk_fp8_f32(v[4] * 8.f, v[5] * 8.f, 0, false);
            w1 = __builtin_amdgcn_cvt_pk_fp8_f32(v[6] * 8.f, v[7] * 8.f, w1, true);
            unsigned char* dst8 = (unsigned char*)(ws + OFF_KV + 2 * KV_STRIDE);
            *(uint2*)(dst8 + ((size_t)(sp - 12) * SEQ + pos) * 64 + 8 * ch) = make_uint2((unsigned)w0, (unsigned)w1);
          } else if (sp <= 17) {
            const int sec = (sp >= 16) ? 4 : ((sp - 8) >> 1);
            const int g = sp & 1;
            uint4 w;
            w.x = pack2(v[0], v[1]); w.y = pack2(v[2], v[3]); w.z = pack2(v[4], v[5]); w.w = pack2(v[6], v[7]);
            bf16_t* dst = (bf16_t*)(ws + OFF_KV + (size_t)sec * KV_STRIDE);
            *(uint4*)(dst + ((size_t)g * SEQ + pos) * 64 + 8 * ch) = w;
          } else if (sp <= 27) {
            {
              const int ug = (sp - 20) * 4 + (ch >> 1);
              uint4 w;
              w.x = pack2(v[0], v[1]); w.y = pack2(v[2], v[3]); w.z = pack2(v[4], v[5]); w.w = pack2(v[6], v[7]);
              *(uint4*)((bf16_t*)(ws + OFF_UB) + ((size_t)(ug * 256 + (pos >> 6)) * 64 + (pos & 63)) * 16 + (ch & 1) * 8) = w;
            }
          } else if (ch < 3) {
            float* dst = GATES + (size_t)pos * 24 + 8 * ch;
            *(float4*)dst = make_float4(sigmoid_f(v[0]), sigmoid_f(v[1]), sigmoid_f(v[2]), sigmoid_f(v[3]));
            *(float4*)(dst + 4) = make_float4(sigmoid_f(v[4]), sigmoid_f(v[5]), sigmoid_f(v[6]), sigmoid_f(v[7]));
          }
        }
      }
      __syncthreads();
    }
  }
  {
    const int G = (int)gridDim.x;
    const int rounds = (128 * 15 + G - 1) / G;
    const int idle_first = 128 * 15 - (rounds - 1) * G;
    int nb = G - idle_first, b0 = (int)blockIdx.x - idle_first;
    if (nb <= 0) { nb = G; b0 = (int)blockIdx.x; }
    if (b0 >= 0) side_jobs(p, smem, b0, nb);
  }
}


#define OFF_WQ_SSM3 (244 * MB + 16384 + 2048)
typedef float v32f_t __attribute__((ext_vector_type(32)));
typedef float v16f_t __attribute__((ext_vector_type(16)));
typedef unsigned v6u_t __attribute__((ext_vector_type(6)));
#ifndef FP6_INTERLEAVED
#define FP6_INTERLEAVED 1
#endif
#define FP6_COL(j) (FP6_INTERLEAVED ? ((((j) & 1) << 4) | ((j) >> 1)) : (j))
__device__ __forceinline__ void convert_item(const Params& p, int item) {
  char* ws = p.ws;
  const int tid = get_tid();
  {
    const int tb = item >> 7;
    const float4* src = (const float4*)(tb ? p.in[24] : p.in[23]);
    unsigned char* dst = (unsigned char*)(ws + OFF_UT + (tb ? 768ull : 0ull));
    const float sc = tb ? 4.f : 64.f;
    const size_t c0 = (size_t)(item & 127) * 4096 + tid;
#pragma unroll 2
    for (size_t c = c0; c < c0 + 4096; c += 256) {
      v16f_t x, y;
#pragma unroll
      for (int i = 0; i < 4; i++) {
        float4 a = src[c * 8 + i], b2 = src[c * 8 + 4 + i];
        x[4 * i + 0] = fminf(fmaxf(a.x * sc, -7.5f), 7.5f);
        x[4 * i + 1] = fminf(fmaxf(a.y * sc, -7.5f), 7.5f);
        x[4 * i + 2] = fminf(fmaxf(a.z * sc, -7.5f), 7.5f);
        x[4 * i + 3] = fminf(fmaxf(a.w * sc, -7.5f), 7.5f);
        y[4 * i + 0] = fminf(fmaxf(b2.x * sc, -7.5f), 7.5f);
        y[4 * i + 1] = fminf(fmaxf(b2.y * sc, -7.5f), 7.5f);
        y[4 * i + 2] = fminf(fmaxf(b2.z * sc, -7.5f), 7.5f);
        y[4 * i + 3] = fminf(fmaxf(b2.w * sc, -7.5f), 7.5f);
      }
      v6u_t w = __builtin_amdgcn_cvt_scalef32_2xpk16_fp6_f32(x, y, 1.0f);
      const size_t row = c >> 5, ckk = c & 31;
      unsigned char* rb = dst + row * 1536;
      *(uint4*)(rb + 16 * ckk) = make_uint4(w[0], w[1], w[2], w[3]);
      *(uint2*)(rb + 512 + 8 * ckk) = make_uint2(w[4], w[5]);
    }
  }
}

__device__ __forceinline__ void dep_wait(unsigned* cnt, unsigned target) {
  if (get_tid() == 0) {
    unsigned sp = 0;
    while (__hip_atomic_load(cnt, __ATOMIC_RELAXED, __HIP_MEMORY_SCOPE_AGENT) < target) {
      __builtin_amdgcn_s_sleep(2);
      if (++sp > (1u << 20)) break;
    }
    __builtin_amdgcn_fence(__ATOMIC_ACQUIRE, "agent");
    asm volatile("s_waitcnt vmcnt(0)" ::: "memory");
  }
  __syncthreads();
}
__device__ __forceinline__ void dep_publish(unsigned* cnt) {
  asm volatile("s_waitcnt vmcnt(0)" ::: "memory");
  __syncthreads();
  if (get_tid() == 0) {
    __builtin_amdgcn_fence(__ATOMIC_RELEASE, "agent");
    asm volatile("s_waitcnt vmcnt(0)" ::: "memory");
    (void)__hip_atomic_fetch_add(cnt, 1u, __ATOMIC_RELAXED, __HIP_MEMORY_SCOPE_AGENT);
  }
}

__device__ __forceinline__ void phase3_task(const Params& p, char* smem, int task) {
  char* ws = p.ws;
  const int lane = get_tid() & 63, wid = get_tid() >> 6, wr = wid >> 1, wc = wid & 1;
  {
    if (task < 32) {
      const int prob = task >> 3, tm = task & 7;
      const int kv = prob >> 1, g = prob & 1;
      const bf16_t* A = (const bf16_t*)(ws + OFF_HID) + (size_t)prob * 1024 * 128;
      const bf16_t* Bt = (const bf16_t*)(ws + (kv ? OFF_W2V : OFF_W2K));
      bf16_t* dst = (bf16_t*)(ws + (kv ? OFF_VC : OFF_KC)) + (size_t)g * 1024 * 64;
      f32x4 acc[4][4];
      gemm_tile_128(A, 128, 1023, Bt, 128, 64, 128, tm * 128, 0, smem, acc);
#pragma unroll
      for (int j = 0; j < 4; j++) {
        const int col = wc * 64 + j * 16 + (lane & 15);
        const bool rope = (kv == 0) && (col < 16);
        const float inv = rope_inv(col & 7);
#pragma unroll
        for (int i = 0; i < 4; i++)
#pragma unroll
          for (int jj = 0; jj < 4; jj++) {
            int row = tm * 128 + wr * 64 + i * 16 + (lane >> 4) * 4 + jj;
            float x = acc[i][j][jj];
            float partner = __shfl_xor(x, 8, 64);
            if (rope) {
              float ang = (float)(row * 16 + 31) * inv;
              float sn, cs;
              sincos_big(ang, sn, cs);
              x = (col < 8) ? (x * cs - partner * sn) : (x * cs + partner * sn);
            }
            if (kv == 0 && row < 1023 && col < 64) dst[(size_t)row * 64 + col] = f2bf(x);
          }
        if (kv == 1 && col < 64) {
#pragma unroll
          for (int i = 0; i < 4; i++) {
            const int row0 = tm * 128 + wr * 64 + i * 16 + (lane >> 4) * 4;
            uint2 w;
            w.x = pack2(acc[i][j][0], acc[i][j][1]);
            w.y = pack2(acc[i][j][2], acc[i][j][3]);
            *(uint2*)(dst + (size_t)col * 1024 + row0) = w;
          }
        }
      }
    } else {
      const int g = task - 32, pp = get_tid() & 63, sg = get_tid() >> 6;
      const float2 l64 = ((const float2*)(ws + OFF_LAM64))[g * 64 + pp];
      const float2* E = (const float2*)(ws + OFF_E) + ((size_t)g * 256 + sg * 64) * 64 + pp;
      bf16_t* CINB = (bf16_t*)(ws + OFF_CINB) + ((size_t)g * 256 + sg * 64) * 128 + pp;
      float2 e[64];
#pragma unroll
      for (int k = 0; k < 64; k++) e[k] = E[(size_t)k * 64];
      float2 t = make_float2(0.f, 0.f);
#pragma unroll
      for (int k = 0; k < 64; k++) {
        float nr = l64.x * t.x - l64.y * t.y + e[k].x;
        float ni = l64.x * t.y + l64.y * t.x + e[k].y;
        t.x = nr;
        t.y = ni;
      }
      float2* sh = (float2*)smem;
      sh[sg * 64 + pp] = t;
      float2 P = l64;
#pragma unroll
      for (int k = 0; k < 6; k++) {
        float nr = P.x * P.x - P.y * P.y;
        float ni = 2.f * P.x * P.y;
        P.x = nr;
        P.y = ni;
      }
      __syncthreads();
      float2 carry = make_float2(0.f, 0.f);
#pragma unroll
      for (int j = 0; j < 3; j++) {
        const float2 tj = sh[j * 64 + pp];
        float nr = P.x * carry.x - P.y * carry.y + tj.x;
        float ni = P.x * carry.y + P.y * carry.x + tj.y;
        if (j < sg) {
          carry.x = nr;
          carry.y = ni;
        }
      }
#pragma unroll
      for (int k = 0; k < 64; k++) {
        CINB[(size_t)k * 128] = f2bf(carry.x);
        CINB[(size_t)k * 128 + 64] = f2bf(carry.y);
        float nr = l64.x * carry.x - l64.y * carry.y + e[k].x;
        float ni = l64.x * carry.y + l64.y * carry.x + e[k].y;
        carry.x = nr;
        carry.y = ni;
      }
      __syncthreads();
    }
  }
}

__device__ __forceinline__ void s5_operator_item(const Params& p, char* smem, int item) {
  char* ws = p.ws;
  const int lane = get_tid() & 63, wid = get_tid() >> 6;
  const int g = item >> 4, d = (item & 15) * 4 + wid;
  float2* Cs = (float2*)smem;
  float2* Gs = (float2*)(smem + 8448 + wid * 8704);
  __syncthreads();
  for (int e = get_tid(); e < 1024; e += 256) Cs[(e >> 6) * 65 + (e & 63)] = make_float2(p.in[14][g * 1024 + e], p.in[15][g * 1024 + e]);
  float2 l1;
  {
    const int gs = g * 64 + lane;
    const float dt = expf(p.in[11][g]);
    const float lr = p.in[9][gs], li = p.in[10][gs];
    const float ang = li * dt;
    float sn, cs;
    sincos_big(ang, sn, cs);
    const float em1 = expm1f(lr * dt);
    const float mag = em1 + 1.f;
    float sh, chh;
    sincos_big(0.5f * ang, sh, chh);
    const float a = em1 * cs - 2.f * sh * sh;
    const float b = mag * sn;
    const float den = lr * lr + li * li;
    const float cr = (a * lr + b * li) / den;
    const float ci = (b * lr - a * li) / den;
    const float pw = (float)d;
    float snd, csd;
    sincos_big(pw * ang, snd, csd);
    const float md = expf(pw * lr * dt);
    const float ldx = md * csd, ldy = md * snd;
    const float fx = ldx * cr - ldy * ci, fy = ldx * ci + ldy * cr;
    l1 = make_float2(ldx * (mag * cs) - ldy * (mag * sn), ldx * (mag * sn) + ldy * (mag * cs));
    const float* bre = p.in[12] + (size_t)gs * 16;
    const float* bim = p.in[13] + (size_t)gs * 16;
#pragma unroll
    for (int c = 0; c < 16; c++) {
      const float xr = bre[c], xi = bim[c];
      Gs[lane * 17 + c] = make_float2(fx * xr - fy * xi, fx * xi + fy * xr);
    }
  }
  __syncthreads();
  {
    bf16_t* Q = (bf16_t*)(ws + OFF_SQ) + ((size_t)g * 1024 + d * 16) * 128;
#pragma unroll 4
    for (int ch = 0; ch < 16; ch++) {
      const float2 cv = Cs[ch * 65 + lane];
      Q[ch * 128 + lane] = f2bf(cv.x * l1.x - cv.y * l1.y);
      Q[ch * 128 + 64 + lane] = f2bf(-(cv.x * l1.y + cv.y * l1.x));
    }
  }
  {
    const int ch = lane >> 2, c4 = (lane & 3) * 4;
    float k0 = 0.f, k1 = 0.f, k2 = 0.f, k3 = 0.f;
#pragma unroll 4
    for (int sidx = 0; sidx < 64; sidx++) {
      const float2 cv = Cs[ch * 65 + sidx];
      const float2 g0 = Gs[sidx * 17 + c4], g1 = Gs[sidx * 17 + c4 + 1], g2 = Gs[sidx * 17 + c4 + 2], g3 = Gs[sidx * 17 + c4 + 3];
      k0 += cv.x * g0.x - cv.y * g0.y;
      k1 += cv.x * g1.x - cv.y * g1.y;
      k2 += cv.x * g2.x - cv.y * g2.y;
      k3 += cv.x * g3.x - cv.y * g3.y;
    }
    bf16_t* KT = (bf16_t*)(ws + OFF_KT) + (((size_t)g * 64 + d) * 16 + ch) * 16 + c4;
    *(uint2*)KT = make_uint2(pack2(k0, k1), pack2(k2, k3));
  }
}
__device__ __forceinline__ void s5_output_tile(const Params& p, char* smem, int item) {
  char* ws = p.ws;
  const int j = 7 - (item >> 6), g = (item & 63) >> 1, m = item & 1;
  f32x4 acc[4][4];
  gemm_tile_128<1, true>((const bf16_t*)(ws + OFF_UB) + (size_t)g * 256 * 1024, 1024, 256, (const bf16_t*)(ws + OFF_KT) + (size_t)g * 64 * 256, 0,
                         1024, 128 * (j + 1), m * 128, j * 128, smem, acc);
  gemm_tile_128<0, false>((const bf16_t*)(ws + OFF_CINB) + (size_t)g * 256 * 128, 128, 256, (const bf16_t*)(ws + OFF_SQ) + (size_t)g * 1024 * 128, 128,
                          1024, 128, m * 128, j * 128, smem, acc);
  const int lane = get_tid() & 63, wid = get_tid() >> 6, wr = wid >> 1, wc = wid & 1;
  const int ch = lane & 15;
  const float dsk = p.in[16][g * 16 + ch];
  const bf16_t* UBg = (const bf16_t*)(ws + OFF_UB) + (size_t)g * 256 * 1024;
  bf16_t* YG = (bf16_t*)(ws + OFF_YG);
#pragma unroll
  for (int i = 0; i < 4; i++)
#pragma unroll
    for (int jj = 0; jj < 4; jj++) {
      const int chunk = m * 128 + wr * 64 + i * 16 + (lane >> 4) * 4 + jj;
#pragma unroll
      for (int jq = 0; jq < 4; jq++) {
        const int t = 8 * j + wc * 4 + jq;
        const float uv = bf2f(UBg[((size_t)chunk * 64 + t) * 16 + ch]);
        YG[((size_t)chunk * 64 + t) * 512 + g * 16 + ch] = f2bf(gelu_tanh(acc[i][jq][jj] + dsk * uv));
      }
    }
}

template <int MODE>
__device__ __forceinline__ void attn_tile_task(const Params& p, int tt, int g, float* impw);
__device__ __forceinline__ void phase2(const Params& p, char* smem) {
  char* ws = p.ws;
  {
    const int G = (int)gridDim.x;
    const int rank = ((G - 33 - (int)blockIdx.x) % G + G) % G;
    const int lane = get_tid() & 63, wid = get_tid() >> 6, wr = wid >> 1, wc = wid & 1;
    for (int et = rank; et < 64; et += G) {
      const int g = et >> 1, half = et & 1;
      f32x4 acc[4][4];
      gemm_tile_128((const bf16_t*)(ws + OFF_SM) + (size_t)g * 128 * 1024, 1024, 128, (const bf16_t*)(ws + OFF_UB) + (size_t)g * 256 * 1024, 1024,
                    256, 1024, 0, half * 128, smem, acc);
      float* E = (float*)(ws + OFF_E);
#pragma unroll
      for (int i = 0; i < 4; i++)
#pragma unroll
        for (int j = 0; j < 4; j++)
#pragma unroll
          for (int jj = 0; jj < 4; jj++) {
            const int st = i * 16 + (lane >> 4) * 4 + jj;
            const int chunk = half * 128 + wc * 64 + j * 16 + (lane & 15);
            E[(((size_t)g * 256 + chunk) * 64 + st) * 2 + wr] = acc[i][j][jj];
          }
    }
  }
  if (((((int)gridDim.x - 33 - (int)blockIdx.x) % (int)gridDim.x + (int)gridDim.x) % (int)gridDim.x) < 64)
    dep_publish((unsigned*)(ws + OFF_WQ_SSM3 + 512));
  {
    const int lane = get_tid() & 63, wid = get_tid() >> 6, wr = wid >> 1, wc = wid & 1;
    for (int task = gridDim.x - 1 - blockIdx.x; task < 32; task += gridDim.x) {
      const int prob = task >> 3, tm = task & 7;
      const int kv = prob >> 1, g = prob & 1;
      const bf16_t* A = (const bf16_t*)(ws + OFF_KV + (size_t)kv * KV_STRIDE) + (size_t)g * SEQ * 64;
      const bf16_t* Bt = (const bf16_t*)(ws + (kv ? OFF_W1V : OFF_W1K));
      const float* bias = (const float*)(ws + (kv ? OFF_BIASV : OFF_BIASK));
      bf16_t* HID = (bf16_t*)(ws + OFF_HID) + (size_t)prob * 1024 * 128;
      f32x4 acc[4][4];
      gemm_tile_128(A, 1024, 1023, Bt, 2048, 128, 2048, tm * 128, 0, smem, acc);
#pragma unroll
      for (int i = 0; i < 4; i++)
#pragma unroll
        for (int j = 0; j < 4; j++)
#pragma unroll
          for (int jj = 0; jj < 4; jj++) {
            int row = tm * 128 + wr * 64 + i * 16 + (lane >> 4) * 4 + jj;
            int col = wc * 64 + j * 16 + (lane & 15);
            if (row < 1023) HID[(size_t)row * 128 + col] = f2bf(gelu_tanh(acc[i][j][jj] + bias[col]));
          }
      asm volatile("s_waitcnt vmcnt(0)" ::: "memory");
      __syncthreads();
      phase3_task(p, smem, task);
    }
  }
  __syncthreads();
  {
    const int nwin = max((int)gridDim.x >> 1, 1);
    if ((int)blockIdx.x < nwin) {
      for (int bt = blockIdx.x; bt < 512; bt += nwin) {
        const int wt = bt * 4 + (get_tid() >> 6);
        attn_tile_task<1>(p, wt >> 1, wt & 1, (float*)smem);
      }
    }
  }
  {
    unsigned* head = (unsigned*)(p.ws + OFF_WQ_SSM3 + 256);
    volatile int* tick = (volatile int*)(smem + SMEM_BYTES - 32);
    for (;;) {
      __syncthreads();
      if (get_tid() == 0) *tick = (int)__hip_atomic_fetch_add(head, 1u, __ATOMIC_RELAXED, __HIP_MEMORY_SCOPE_AGENT);
      __syncthreads();
      const int item0 = *tick;
      if (item0 >= 32 + 512 + 256 + 224) break;
      if (item0 >= 512 + 256 + 224) {
        dep_wait((unsigned*)(ws + OFF_WQ_SSM3 + 512), min(64u, (unsigned)gridDim.x));
        phase3_task(p, smem, 32 + item0 - (512 + 256 + 224));
        continue;
      }
      if (item0 >= 256 + 224) {
        s5_operator_item(p, smem, item0 - (256 + 224));
        continue;
      }
      const int item = item0;
      if (item < 256) {
        convert_item(p, item);
      } else {
        if (item - 256 < 96) {
          for (int k = 0; k < 4; k++) {
            const int t = (item - 256) * 4 + k;
            if (t < 128) transpose_job(p.in[17], 512, 1024, (bf16_t*)(ws + OFF_WGLU), 1024, 2, t, smem);
            else transpose_job(p.in[18], 1024, 1024, (bf16_t*)(ws + OFF_WOUT), 1024, 0, t - 128, smem);
          }
        } else {
          const int w = item - 256 - 96, hh = w >> 3, kt = w & 7;
          f32x4 acc[4][4];
          gemm_tile_128((const bf16_t*)(ws + OFF_SUBT) + (size_t)(hh & 1) * 128 * 128, 128, 128, (const bf16_t*)(ws + OFF_WQB) + hh * 128, 2048,
                        1024, 128, 0, kt * 128, smem, acc);
          const int lane = get_tid() & 63, wid = get_tid() >> 6, wr = wid >> 1, wc = wid & 1;
          bf16_t* WP = (bf16_t*)(ws + OFF_WQ) + (size_t)hh * 128 * 1024 + kt * 128;
#pragma unroll
          for (int i = 0; i < 4; i++)
#pragma unroll
            for (int j = 0; j < 4; j++)
#pragma unroll
              for (int jj = 0; jj < 4; jj++)
                WP[(size_t)(wr * 64 + i * 16 + (lane >> 4) * 4 + jj) * 1024 + wc * 64 + j * 16 + (lane & 15)] = f2bf(acc[i][j][jj]);
        }
      }
    }
  }
}

#define LOG2E_F 1.4426950408889634f
#define NEGC (-1e30f)
#define IMP_STRIDE 258
__device__ __forceinline__ bf16x8 ldfrag(const bf16_t* p) { return *(const bf16x8*)p; }
__device__ __forceinline__ bf16x8 pack8(const float (&v)[8]) {
  u32x4 w = {pack2(v[0], v[1]), pack2(v[2], v[3]), pack2(v[4], v[5]), pack2(v[6], v[7])};
  return __builtin_bit_cast(bf16x8, w);
}
__device__ __forceinline__ float ex2(float x) { return __builtin_amdgcn_exp2f(x); }
__device__ __forceinline__ void qk_tile(const bf16x8 (&kf)[4], const bf16x8& q0, const bf16x8& q1, f32x4& sa, f32x4& sb) {
  const f32x4 z = {0.f, 0.f, 0.f, 0.f};
  sa = __builtin_amdgcn_mfma_f32_16x16x32_bf16(kf[0], q0, z, 0, 0, 0);
  sa = __builtin_amdgcn_mfma_f32_16x16x32_bf16(kf[1], q1, sa, 0, 0, 0);
  sb = __builtin_amdgcn_mfma_f32_16x16x32_bf16(kf[2], q0, z, 0, 0, 0);
  sb = __builtin_amdgcn_mfma_f32_16x16x32_bf16(kf[3], q1, sb, 0, 0, 0);
}
__device__ __forceinline__ void load_k(bf16x8 (&kf)[4], const bf16_t* kr) {
  kf[0] = ldfrag(kr);
  kf[1] = ldfrag(kr + 32);
  kf[2] = ldfrag(kr + 256);
  kf[3] = ldfrag(kr + 288);
}
__device__ __forceinline__ void load_v(bf16x8 (&vf)[4], const bf16_t* vr, size_t ldv16) {
  vf[0] = ldfrag(vr);
  vf[1] = ldfrag(vr + ldv16);
  vf[2] = ldfrag(vr + 2 * ldv16);
  vf[3] = ldfrag(vr + 3 * ldv16);
}

template <int MODE>
__device__ __forceinline__ void attn_tile_task(const Params& p, int tt, int g, float* impw) {
  char* ws = p.ws;
  const int lane = get_tid() & 63, col = lane & 15, q = lane >> 4;
  const int t0 = tt * 16, tok = t0 + col;
  const bf16_t* Qp = (const bf16_t*)(ws + OFF_Q) + ((size_t)tok * 8 + g * 4) * 64 + 8 * q;
  const bf16_t* Kb;
  const bf16_t* Vb;
  size_t ldv;
  int kt_lo, kt_hi;
  if (MODE == 0) {
    Kb = (const bf16_t*)(ws + OFF_KC) + (size_t)g * 1024 * 64;
    Vb = (const bf16_t*)(ws + OFF_VC) + (size_t)g * 64 * 1024;
    ldv = 1024;
    kt_lo = 0;
    kt_hi = (t0 + 15 >= 31) ? (((t0 + 15 - 31) >> 4) >> 5) : -1;
  } else {
    Kb = (const bf16_t*)(ws + OFF_KV + 4 * KV_STRIDE) + (size_t)g * SEQ * 64;
    Vb = (const bf16_t*)(ws + OFF_KV + 5 * KV_STRIDE) + (size_t)g * 64 * SEQ;
    ldv = SEQ;
    kt_lo = max(t0 - 511, 0) >> 5;
    kt_hi = (t0 + 15) >> 5;
  }
  const int hi_lim = (MODE == 0) ? ((tok >= 31) ? ((tok - 31) >> 4) : -1) : tok;
  const int lo_lim = (MODE == 0) ? 0 : tok - 511;
  bf16x8 qf[4][2];
#pragma unroll
  for (int h = 0; h < 4; h++) {
    qf[h][0] = ldfrag(Qp + h * 64);
    qf[h][1] = ldfrag(Qp + h * 64 + 32);
  }
  const int mA = 8 * (col >> 2) + (col & 3);
  const bf16_t* Krow = Kb + (size_t)mA * 64 + 8 * q;
  const bf16_t* Vrow = Vb + (size_t)col * ldv + 8 * q;
  const size_t ldv16 = 16 * ldv;
  float mrun[4], lrun[4];
#pragma unroll
  for (int h = 0; h < 4; h++) { mrun[h] = NEGC; lrun[h] = 0.f; }

  const int hi_min = (MODE == 0) ? ((t0 >= 31) ? ((t0 - 31) >> 4) : -1) : t0;
  const int lo_max = (MODE == 0) ? 0 : t0 + 15 - 511;
  auto body1 = [&](const bf16x8 (&kf)[4], int kt, auto masked) __attribute__((always_inline)) {
    constexpr bool MK = decltype(masked)::value;
    const int key0 = kt * 32 + 8 * q;
#pragma unroll
    for (int h = 0; h < 4; h++) {
      f32x4 sa, sb;
      qk_tile(kf, qf[h][0], qf[h][1], sa, sb);
      float s[8];
      bool v[8];
#pragma unroll
      for (int r = 0; r < 4; r++) {
        if (MK) {
          int ka = key0 + r, kb2 = key0 + 4 + r;
          v[r] = (ka <= hi_lim) && (ka >= lo_lim);
          v[4 + r] = (kb2 <= hi_lim) && (kb2 >= lo_lim);
          s[r] = v[r] ? sa[r] * LOG2E_F : NEGC;
          s[4 + r] = v[4 + r] ? sb[r] * LOG2E_F : NEGC;
        } else {
          v[r] = true;
          v[4 + r] = true;
          s[r] = sa[r] * LOG2E_F;
          s[4 + r] = sb[r] * LOG2E_F;
        }
      }
      float tm = fmaxf(fmaxf(fmaxf(s[0], s[1]), fmaxf(s[2], s[3])), fmaxf(fmaxf(s[4], s[5]), fmaxf(s[6], s[7])));
      float mn = fmaxf(mrun[h], tm);
      if (MODE == 0) {
        float e = 0.f;
#pragma unroll
        for (int r = 0; r < 8; r++) e += (!MK || v[r]) ? ex2(s[r] - mn) : 0.f;
        lrun[h] = lrun[h] * ex2(mrun[h] - mn) + e;
      }
      mrun[h] = mn;
    }
  };
  auto run1 = [&](const bf16x8 (&kf)[4], int kt) __attribute__((always_inline)) {
    if (32 * kt + 31 <= hi_min && 32 * kt >= lo_max) body1(kf, kt, std::false_type{});
    else body1(kf, kt, std::true_type{});
  };
  if (kt_lo <= kt_hi) {
    bf16x8 kA[4], kB[4];
    load_k(kA, Krow + (size_t)kt_lo * 2048);
    for (int kt = kt_lo; kt <= kt_hi; kt += 2) {
      if (kt + 1 <= kt_hi) load_k(kB, Krow + (size_t)(kt + 1) * 2048);
      run1(kA, kt);
      if (kt + 1 <= kt_hi) {
        if (kt + 2 <= kt_hi) load_k(kA, Krow + (size_t)(kt + 2) * 2048);
        run1(kB, kt + 1);
      }
    }
  }
  float inv[4];
#pragma unroll
  for (int h = 0; h < 4; h++) {
    float ma = fmaxf(mrun[h], __shfl_xor(mrun[h], 16, 64));
    ma = fmaxf(ma, __shfl_xor(ma, 32, 64));
    if (MODE == 0) {
      float ls = lrun[h] * ex2(mrun[h] - ma);
      ls += __shfl_xor(ls, 16, 64);
      ls += __shfl_xor(ls, 32, 64);
      inv[h] = (ls > 0.f) ? (1.f / ls) : 0.f;
    } else {
      inv[h] = 1.f;
      lrun[h] = 0.f;
    }
    mrun[h] = (MODE == 0) ? ((inv[h] > 0.f) ? ma - __log2f(inv[h]) : 1e30f) : ma;
  }

  f32x4 o[4][4];
#pragma unroll
  for (int h = 0; h < 4; h++)
#pragma unroll
    for (int mt = 0; mt < 4; mt++) o[h][mt] = (f32x4){0.f, 0.f, 0.f, 0.f};
  float carry = 0.f;
  auto body2 = [&](const bf16x8 (&kf)[4], const bf16x8 (&vf)[4], int kt, auto masked) __attribute__((always_inline)) {
    constexpr bool MK = decltype(masked)::value;
    const int key0 = kt * 32 + 8 * q;
    float a4 = 0.f, b4 = 0.f, p3h = 0.f, p7h = 0.f;
#pragma unroll
    for (int h = 0; h < 4; h++) {
      f32x4 sa, sb;
      qk_tile(kf, qf[h][0], qf[h][1], sa, sb);
      float pr[8];
#pragma unroll
      for (int r = 0; r < 4; r++) {
        if (MK) {
          int ka = key0 + r, kb2 = key0 + 4 + r;
          bool va = (ka <= hi_lim) && (ka >= lo_lim);
          bool vb = (kb2 <= hi_lim) && (kb2 >= lo_lim);
          pr[r] = va ? ex2(sa[r] * LOG2E_F - mrun[h]) : 0.f;
          pr[4 + r] = vb ? ex2(sb[r] * LOG2E_F - mrun[h]) : 0.f;
        } else {
          pr[r] = ex2(sa[r] * LOG2E_F - mrun[h]);
          pr[4 + r] = ex2(sb[r] * LOG2E_F - mrun[h]);
        }
      }
      if (MODE == 1) lrun[h] += ((pr[0] + pr[1]) + (pr[2] + pr[3])) + ((pr[4] + pr[5]) + (pr[6] + pr[7]));
      bf16x8 pk = pack8(pr);
#pragma unroll
      for (int mt = 0; mt < 4; mt++) o[h][mt] = __builtin_amdgcn_mfma_f32_16x16x32_bf16(vf[mt], pk, o[h][mt], 0, 0, 0);
      if (MODE == 0) {
        a4 += (pr[0] + pr[1]) + (pr[2] + pr[3]);
        b4 += (pr[4] + pr[5]) + (pr[6] + pr[7]);
        p3h += pr[3];
        p7h += pr[7];
      }
    }
    if (MODE == 0) {
      float rot = __shfl(p7h, (lane + 48) & 63, 64);
      float val = (q == 0) ? carry : rot;
      carry = rot;
      const int m = 8 * kt + 2 * q;
      *(float2*)&impw[col * IMP_STRIDE + m] = make_float2(val + a4, p3h + b4);
    }
  };
  auto run2 = [&](const bf16x8 (&kf)[4], const bf16x8 (&vf)[4], int kt) __attribute__((always_inline)) {
    if (32 * kt + 31 <= hi_min && 32 * kt >= lo_max) body2(kf, vf, kt, std::false_type{});
    else body2(kf, vf, kt, std::true_type{});
  };
  if (kt_lo <= kt_hi) {
    bf16x8 kA[4], kB[4], vA[4], vB[4];
    load_k(kA, Krow + (size_t)kt_lo * 2048);
    load_v(vA, Vrow + (size_t)kt_lo * 32, ldv16);
    for (int kt = kt_lo; kt <= kt_hi; kt += 2) {
      if (kt + 1 <= kt_hi) {
        load_k(kB, Krow + (size_t)(kt + 1) * 2048);
        load_v(vB, Vrow + (size_t)(kt + 1) * 32, ldv16);
      }
      run2(kA, vA, kt);
      if (kt + 1 <= kt_hi) {
        if (kt + 2 <= kt_hi) {
          load_k(kA, Krow + (size_t)(kt + 2) * 2048);
          load_v(vA, Vrow + (size_t)(kt + 2) * 32, ldv16);
        }
        run2(kB, vB, kt + 1);
      }
    }
  }
  if (MODE == 1) {
#pragma unroll
    for (int h = 0; h < 4; h++) {
      float ls = lrun[h];
      ls += __shfl_xor(ls, 16, 64);
      ls += __shfl_xor(ls, 32, 64);
      const float iv = (ls > 0.f) ? (1.f / ls) : 0.f;
#pragma unroll
      for (int mt = 0; mt < 4; mt++) o[h][mt] = o[h][mt] * iv;
    }
  }
  {
    bf16_t* dst = (bf16_t*)(ws + OFF_Z + (MODE == 0 ? 0ull : 16 * MB)) + (size_t)tok * 512 + g * 256 + 4 * q;
#pragma unroll
    for (int h = 0; h < 4; h++)
#pragma unroll
      for (int mt = 0; mt < 4; mt++) {
        uint2 w;
        w.x = pack2(o[h][mt][0], o[h][mt][1]);
        w.y = pack2(o[h][mt][2], o[h][mt][3]);
        *(uint2*)(dst + h * 64 + mt * 16) = w;
      }
  }
  if (MODE == 0) {
    wave_lds_sync();
    unsigned char* SEL = (unsigned char*)(ws + OFF_HID);
#pragma unroll 1
    for (int rd = 0; rd < 4; rd++) {
      const int tsel = 4 * rd + q;
      const int tk = t0 + tsel;
      const int cur = tk >> 6;
      unsigned kk[16];
#pragma unroll
      for (int c = 0; c < 16; c++) {
        const int m = col + 16 * c;
        unsigned bits = __float_as_uint(impw[tsel * IMP_STRIDE + m]);
        kk[c] = (m >= 1 && m <= cur - 2) ? ((bits & 0xFFFFFF00u) | (unsigned)(255 - m)) : 0u;
      }
      unsigned myidx = 0;
#pragma unroll 1
      for (int r = 0; r < 13; r++) {
        unsigned w = kk[0];
#pragma unroll
        for (int c = 1; c < 16; c++) w = max(w, kk[c]);
        w = max(w, (unsigned)__builtin_amdgcn_update_dpp(0u, w, 0x128, 0xF, 0xF, false));
        w = max(w, (unsigned)__builtin_amdgcn_update_dpp(0u, w, 0x124, 0xF, 0xF, false));
        w = max(w, (unsigned)__builtin_amdgcn_update_dpp(0u, w, 0x122, 0xF, 0xF, false));
        w = max(w, (unsigned)__builtin_amdgcn_update_dpp(0u, w, 0x121, 0xF, 0xF, false));
        if (col == r) myidx = 255u - (w & 255u);
#pragma unroll
        for (int c = 0; c < 16; c++) kk[c] = (kk[c] == w) ? 0u : kk[c];
      }
      if (cur >= 16) {
        unsigned char* sp = SEL + ((size_t)tk * 2 + g) * 16;
        if (col < 13) sp[3 + col] = (unsigned char)myidx;
        if (col == 13) sp[0] = 0;
        if (col == 14) sp[1] = (unsigned char)(cur - 1);
        if (col == 15) sp[2] = (unsigned char)cur;
      }
    }
    wave_lds_sync();
  }
}

__device__ __forceinline__ long mk64(unsigned lo, unsigned hi) { return (long)(((unsigned long long)hi << 32) | (unsigned long long)lo); }
__device__ __forceinline__ f32x4 mfma8(long a, long b, f32x4 c) { return __builtin_amdgcn_mfma_f32_16x16x32_fp8_fp8(a, b, c, 0, 0, 0); }
__device__ __forceinline__ void attn_sel_task(const Params& p, int t0, int g, char* wlds) {
  char* ws = p.ws;
  const int lane = get_tid() & 63, col = lane & 15, q = lane >> 4;
  const int tok = col >> 2, hd = col & 3, t = t0 + tok;
  long q0, q1;
  {
    const bf16_t* Qp = (const bf16_t*)(ws + OFF_Q) + ((size_t)t * 8 + g * 4 + hd) * 64 + 16 * q;
    uint4 qa = *(const uint4*)Qp, qb = *(const uint4*)(Qp + 8);
    const float sc = 64.f;
    int w0 = __builtin_amdgcn_cvt_pk_fp8_f32(bflo(qa.x) * sc, bfhi(qa.x) * sc, 0, false);
    w0 = __builtin_amdgcn_cvt_pk_fp8_f32(bflo(qa.y) * sc, bfhi(qa.y) * sc, w0, true);
    int w1 = __builtin_amdgcn_cvt_pk_fp8_f32(bflo(qa.z) * sc, bfhi(qa.z) * sc, 0, false);
    w1 = __builtin_amdgcn_cvt_pk_fp8_f32(bflo(qa.w) * sc, bfhi(qa.w) * sc, w1, true);
    int w2 = __builtin_amdgcn_cvt_pk_fp8_f32(bflo(qb.x) * sc, bfhi(qb.x) * sc, 0, false);
    w2 = __builtin_amdgcn_cvt_pk_fp8_f32(bflo(qb.y) * sc, bfhi(qb.y) * sc, w2, true);
    int w3 = __builtin_amdgcn_cvt_pk_fp8_f32(bflo(qb.z) * sc, bfhi(qb.z) * sc, 0, false);
    w3 = __builtin_amdgcn_cvt_pk_fp8_f32(bflo(qb.w) * sc, bfhi(qb.w) * sc, w3, true);
    q0 = mk64((unsigned)w0, (unsigned)w1);
    q1 = mk64((unsigned)w2, (unsigned)w3);
  }
  const unsigned char* Krow = (const unsigned char*)(ws + OFF_KV + 2 * KV_STRIDE) + (size_t)g * SEQ * 64 +
                              (size_t)(16 * (col >> 2) + (col & 3)) * 64 + 16 * q;
  const unsigned char* Vrow = (const unsigned char*)(ws + OFF_KV + 3 * KV_STRIDE) + (size_t)g * 256 * 4096 + (size_t)col * 64 + 16 * q;
  const int cur = t0 >> 6;
  LAS unsigned* flags = (LAS unsigned*)wlds;
  LAS unsigned* list = (LAS unsigned*)(wlds + 256);
  wave_lds_sync();
  flags[lane] = 0u;
  wave_lds_sync();
  {
    const int tk = lane >> 4, e = lane & 15;
    int id = -1;
    if (cur >= 16) id = (int)((const unsigned char*)(ws + OFF_HID))[((size_t)(t0 + tk) * 2 + g) * 16 + e];
    else if (e <= cur) id = e;
    if (id >= 0) (void)__hip_atomic_fetch_or(&flags[id >> 2], (1u << tk) << (8 * (id & 3)), __ATOMIC_RELAXED, __HIP_MEMORY_SCOPE_WORKGROUP);
  }
  wave_lds_sync();
  int n = 0;
  {
    const unsigned fw = flags[lane];
    const unsigned long long lt = (1ull << lane) - 1ull;
#pragma unroll
    for (int qq = 0; qq < 4; qq++) {
      const unsigned m = (fw >> (8 * qq)) & 15u;
      const unsigned long long bal = __ballot(m != 0u);
      if (m != 0u) list[n + __popcll(bal & lt)] = (unsigned)(4 * lane + qq) | (m << 8);
      n += __popcll(bal);
    }
  }
  wave_lds_sync();
  auto load_blk = [&](u32x4 (&kf)[4], u32x4 (&vf)[4], int blk) __attribute__((always_inline)) {
    const unsigned char* kr = Krow + (size_t)blk * 4096;
    kf[0] = *(const u32x4*)(kr);
    kf[1] = *(const u32x4*)(kr + 256);
    kf[2] = *(const u32x4*)(kr + 512);
    kf[3] = *(const u32x4*)(kr + 768);
    const unsigned char* vr = Vrow + (size_t)blk * 4096;
    vf[0] = *(const u32x4*)(vr);
    vf[1] = *(const u32x4*)(vr + 1024);
    vf[2] = *(const u32x4*)(vr + 2048);
    vf[3] = *(const u32x4*)(vr + 3072);
  };
  float mrun = -1.0e4f, lrun = 0.f;
  f32x4 o[4];
#pragma unroll
  for (int mt = 0; mt < 4; mt++) o[mt] = (f32x4){0.f, 0.f, 0.f, 0.f};
  const float SSC = LOG2E_F * (1.f / 512.f);
  auto body = [&](const u32x4 (&kf)[4], const u32x4 (&vf)[4], unsigned ent) __attribute__((always_inline)) {
    const int blk = (int)(ent & 255u);
    const unsigned msk = ent >> 8;
    const bool valid = ((msk >> tok) & 1u) != 0u;
    const f32x4 z = {0.f, 0.f, 0.f, 0.f};
    f32x4 sa0 = mfma8(mk64(kf[0].x, kf[0].y), q0, z);
    sa0 = mfma8(mk64(kf[0].z, kf[0].w), q1, sa0);
    f32x4 sb0 = mfma8(mk64(kf[1].x, kf[1].y), q0, z);
    sb0 = mfma8(mk64(kf[1].z, kf[1].w), q1, sb0);
    f32x4 sa1 = mfma8(mk64(kf[2].x, kf[2].y), q0, z);
    sa1 = mfma8(mk64(kf[2].z, kf[2].w), q1, sa1);
    f32x4 sb1 = mfma8(mk64(kf[3].x, kf[3].y), q0, z);
    sb1 = mfma8(mk64(kf[3].z, kf[3].w), q1, sb1);
    float s[16];
#pragma unroll
    for (int r = 0; r < 4; r++) {
      s[r] = sa0[r];
      s[4 + r] = sb0[r];
      s[8 + r] = sa1[r];
      s[12 + r] = sb1[r];
    }
    if (blk == cur) {
      const int key0 = blk * 64 + 16 * q;
      const int lim = valid ? t : -1;
#pragma unroll
      for (int r = 0; r < 8; r++) {
        s[r] = (key0 + r <= lim) ? s[r] : -1e30f;
        s[8 + r] = (key0 + 8 + r <= lim) ? s[8 + r] : -1e30f;
      }
    }
    float tm = fmaxf(fmaxf(fmaxf(s[0], s[1]), fmaxf(s[2], s[3])), fmaxf(fmaxf(s[4], s[5]), fmaxf(s[6], s[7])));
    float tm2 = fmaxf(fmaxf(fmaxf(s[8], s[9]), fmaxf(s[10], s[11])), fmaxf(fmaxf(s[12], s[13]), fmaxf(s[14], s[15])));
    tm = fmaxf(tm, tm2);
    tm = valid ? tm : -1e30f;
    tm *= SSC;
    if (!__all(tm <= mrun + 1.0f)) {
      tm = fmaxf(tm, __shfl_xor(tm, 16, 64));
      tm = fmaxf(tm, __shfl_xor(tm, 32, 64));
      const float mn = fmaxf(mrun, tm);
      const float alpha = ex2(mrun - mn);
      mrun = mn;
      lrun *= alpha;
#pragma unroll
      for (int mt = 0; mt < 4; mt++) {
        o[mt][0] *= alpha; o[mt][1] *= alpha; o[mt][2] *= alpha; o[mt][3] *= alpha;
      }
    }
    float pr[16];
    const float mb = valid ? 7.f - mrun : -1e30f;
#pragma unroll
    for (int r = 0; r < 16; r++) pr[r] = ex2(__builtin_fmaf(s[r], SSC, mb));
    lrun += ((pr[0] + pr[1]) + (pr[2] + pr[3])) + ((pr[4] + pr[5]) + (pr[6] + pr[7])) +
            ((pr[8] + pr[9]) + (pr[10] + pr[11])) + ((pr[12] + pr[13]) + (pr[14] + pr[15]));
    int w0 = __builtin_amdgcn_cvt_pk_fp8_f32(pr[0], pr[1], 0, false);
    w0 = __builtin_amdgcn_cvt_pk_fp8_f32(pr[2], pr[3], w0, true);
    int w1 = __builtin_amdgcn_cvt_pk_fp8_f32(pr[4], pr[5], 0, false);
    w1 = __builtin_amdgcn_cvt_pk_fp8_f32(pr[6], pr[7], w1, true);
    int w2 = __builtin_amdgcn_cvt_pk_fp8_f32(pr[8], pr[9], 0, false);
    w2 = __builtin_amdgcn_cvt_pk_fp8_f32(pr[10], pr[11], w2, true);
    int w3 = __builtin_amdgcn_cvt_pk_fp8_f32(pr[12], pr[13], 0, false);
    w3 = __builtin_amdgcn_cvt_pk_fp8_f32(pr[14], pr[15], w3, true);
    const long pk0 = mk64((unsigned)w0, (unsigned)w1), pk1 = mk64((unsigned)w2, (unsigned)w3);
#pragma unroll
    for (int mt = 0; mt < 4; mt++) {
      o[mt] = mfma8(mk64(vf[mt].x, vf[mt].y), pk0, o[mt]);
      o[mt] = mfma8(mk64(vf[mt].z, vf[mt].w), pk1, o[mt]);
    }
  };
  {
    u32x4 kA[4], vA[4], kB[4], vB[4];
    unsigned entA = (unsigned)__builtin_amdgcn_readfirstlane((int)list[0]), entB = 0u;
    load_blk(kA, vA, (int)(entA & 255u));
#pragma unroll 1
    for (int b = 0; b < n; b += 2) {
      if (b + 1 < n) {
        entB = (unsigned)__builtin_amdgcn_readfirstlane((int)list[b + 1]);
        load_blk(kB, vB, (int)(entB & 255u));
      }
      body(kA, vA, entA);
      if (b + 1 < n) {
        if (b + 2 < n) {
          entA = (unsigned)__builtin_amdgcn_readfirstlane((int)list[b + 2]);
          load_blk(kA, vA, (int)(entA & 255u));
        }
        body(kB, vB, entB);
      }
    }
  }
  {
    float ls = lrun;
    ls += __shfl_xor(ls, 16, 64);
    ls += __shfl_xor(ls, 32, 64);
    const float inv = (ls > 0.f) ? (0.125f / ls) : 0.f;
#pragma unroll
    for (int mt = 0; mt < 4; mt++) {
      o[mt][0] *= inv; o[mt][1] *= inv; o[mt][2] *= inv; o[mt][3] *= inv;
    }
  }
  {
    const float* gt = (const float*)(ws + OFF_GATES) + (size_t)t * 24 + (g * 4 + hd) * 3;
    const float gc = gt[0], gs = gt[1], gw = gt[2];
    const size_t off = (size_t)t * 512 + (g * 4 + hd) * 64 + 4 * q;
    const bf16_t* OC = (const bf16_t*)(ws + OFF_Z) + off;
    const bf16_t* OW = (const bf16_t*)(ws + OFF_Z + 16 * MB) + off;
    bf16_t* MIX = (bf16_t*)(ws + OFF_MIX) + (size_t)t * 1024 + (g * 4 + hd) * 64 + 4 * q;
#pragma unroll
    for (int mt = 0; mt < 4; mt++) {
      uint2 c2 = *(const uint2*)(OC + mt * 16);
      uint2 w2 = *(const uint2*)(OW + mt * 16);
      float r0 = gc * bflo(c2.x) + gs * o[mt][0] + gw * bflo(w2.x);
      float r1 = gc * bfhi(c2.x) + gs * o[mt][1] + gw * bfhi(w2.x);
      float r2 = gc * bflo(c2.y) + gs * o[mt][2] + gw * bflo(w2.y);
      float r3 = gc * bfhi(c2.y) + gs * o[mt][3] + gw * bfhi(w2.y);
      uint2 wv;
      wv.x = pack2(r0, r1);
      wv.y = pack2(r2, r3);
      *(uint2*)(MIX + mt * 16) = wv;
    }
  }
}
__device__ __forceinline__ void phase4(const Params& p, char* smem) {
  const int wid = get_tid() >> 6;
  float* impw = (float*)(smem + wid * (16 * IMP_STRIDE * 4));
  {
    const int half = max((int)gridDim.x >> 1, 1);
    if ((int)blockIdx.x < half) {
      for (int pw = blockIdx.x * 4 + wid; pw < 1024; pw += half * 4) {
        const int g = pw & 1, k = pw >> 1;
        attn_tile_task<0>(p, 1023 - k, g, impw);
        attn_tile_task<0>(p, k, g, impw);
      }
    }
  }
  unsigned* head = (unsigned*)(p.ws + OFF_WQ_SSM3);
  volatile int* tick = (volatile int*)(smem + SMEM_BYTES - 32);
  for (;;) {
    __syncthreads();
    if (get_tid() == 0) *tick = (int)__hip_atomic_fetch_add(head, 1u, __ATOMIC_RELAXED, __HIP_MEMORY_SCOPE_AGENT);
    __syncthreads();
    const int task = *tick;
    if (task >= 512) break;
    s5_output_tile(p, smem, task);
  }
}
__device__ __forceinline__ unsigned hw_xcc_id() { return (unsigned)__builtin_amdgcn_s_getreg((3 << 11) | 20) & 0x7u; }
#define OFF_WQ_CNT (244 * MB + 16384)
__device__ __forceinline__ void phase4b(const Params& p, char* smem) {
  const int wid = get_tid() >> 6;
  unsigned* qcnt = (unsigned*)(p.ws + OFF_WQ_CNT);
  volatile int* tick = (volatile int*)(smem + SMEM_BYTES - 32);
  const unsigned x = hw_xcc_id();
  for (int k = 0; k < 8; k++) {
    const int part = (int)((x + k) & 7u);
    const int g = part & 1, quarter = part >> 1;
    for (;;) {
      __syncthreads();
      if (get_tid() == 0) *tick = (int)__hip_atomic_fetch_add(&qcnt[part * 64], 1u, __ATOMIC_RELAXED, __HIP_MEMORY_SCOPE_AGENT);
      __syncthreads();
      const int bt = *tick;
      if (bt >= 256) break;
      const int t0 = quarter * 4096 + 16 * (255 - bt) + 4 * wid;
      attn_sel_task(p, t0, g, smem + wid * 512);
    }
  }
}

__device__ __forceinline__ void phase5(const Params& p, char* smem) {
  char* ws = p.ws;
  const int lane = get_tid() & 63, wid = get_tid() >> 6, wr = wid >> 1, wc = wid & 1;
  const bf16_t* YG = (const bf16_t*)(ws + OFF_YG);
  const bf16_t* W = (const bf16_t*)(ws + OFF_WGLU);
  bf16_t* MIX = (bf16_t*)(ws + OFF_MIX);
  for (int tile = blockIdx.x; tile < 128 * 8; tile += gridDim.x) {
    const int tm = tile >> 3, tn = tile & 7;
    f32x4 acc[4][4];
    gemm_tile_128(YG, 512, SEQ, W, 512, 1024, 512, tm * 128, tn * 128, smem, acc);
    const int b64 = tn * 2 + wc;
    {
      const float* t = stage_acc(acc, smem);
      const int rs = lane >> 2, c8 = (lane & 3) * 8;
#pragma unroll
      for (int it = 0; it < 4; it++) {
        const int r = it * 16 + rs;
        const float* tr = t + r * EPI_LD;
        float4 a0 = *(const float4*)(tr + c8), a1 = *(const float4*)(tr + c8 + 4);
        float4 b0 = *(const float4*)(tr + 32 + c8), b1 = *(const float4*)(tr + 32 + c8 + 4);
        uint4 w;
        w.x = pack2(a0.x * sigmoid_f(b0.x), a0.y * sigmoid_f(b0.y));
        w.y = pack2(a0.z * sigmoid_f(b0.z), a0.w * sigmoid_f(b0.w));
        w.z = pack2(a1.x * sigmoid_f(b1.x), a1.y * sigmoid_f(b1.y));
        w.w = pack2(a1.z * sigmoid_f(b1.z), a1.w * sigmoid_f(b1.w));
        *(uint4*)(MIX + (size_t)(tm * 128 + wr * 64 + r) * 1024 + 512 + 32 * b64 + c8) = w;
      }
      __syncthreads();
    }
  }
}

__device__ __forceinline__ void phase6(const Params& p, char* smem) {
  char* ws = p.ws;
  const int lane = get_tid() & 63, wid = get_tid() >> 6, wr = wid >> 1, wc = wid & 1;
  const bf16_t* MIX = (const bf16_t*)(ws + OFF_MIX);
  const bf16_t* W = (const bf16_t*)(ws + OFF_WOUT);
  const float* x = p.in[0];
  float* h1 = p.out;
  for (int tile = blockIdx.x; tile < 128 * 8; tile += gridDim.x) {
    const int tm = tile >> 3, tn = tile & 7;
    f32x4 acc[4][4];
    gemm_tile_128(MIX, 1024, SEQ, W, 1024, 1024, 1024, tm * 128, tn * 128, smem, acc);
    {
      const float* t = stage_acc(acc, smem);
      const int rs = lane >> 4, c4 = (lane & 15) * 4;
      const float4 gg = *(const float4*)(p.in[19] + tn * 128 + wc * 64 + c4);
      bf16_t* XW = (bf16_t*)(ws + OFF_Z);
      float* SSQ = (float*)(ws + OFF_SSQ);
#pragma unroll 4
      for (int it = 0; it < 16; it++) {
        const int r = it * 4 + rs;
        const size_t row = (size_t)(tm * 128 + wr * 64 + r);
        const size_t o = row * 1024 + tn * 128 + wc * 64 + c4;
        float4 a = *(const float4*)(t + r * EPI_LD + c4);
        float4 xv = *(const float4*)(x + o);
        const float4 hv = make_float4(xv.x + a.x, xv.y + a.y, xv.z + a.z, xv.w + a.w);
        *(float4*)(h1 + o) = hv;
        uint2 w;
        w.x = pack2(hv.x * gg.x, hv.y * gg.y);
        w.y = pack2(hv.z * gg.z, hv.w * gg.w);
        *(uint2*)(XW + o) = w;
        float ss = (hv.x * hv.x + hv.y * hv.y) + (hv.z * hv.z + hv.w * hv.w);
        ss += __uint_as_float((unsigned)__builtin_amdgcn_update_dpp(0u, __float_as_uint(ss), 0x128, 0xF, 0xF, false));
        ss += __uint_as_float((unsigned)__builtin_amdgcn_update_dpp(0u, __float_as_uint(ss), 0x124, 0xF, 0xF, false));
        ss += __uint_as_float((unsigned)__builtin_amdgcn_update_dpp(0u, __float_as_uint(ss), 0x122, 0xF, 0xF, false));
        ss += __uint_as_float((unsigned)__builtin_amdgcn_update_dpp(0u, __float_as_uint(ss), 0x121, 0xF, 0xF, false));
        if ((lane & 15) == 0) SSQ[row * 16 + tn * 2 + wc] = ss;
      }
      __syncthreads();
    }
  }
}

#define OFF_TOPV (112 * MB)
#define OFF_TOPI (OFF_TOPV + 16 * MB)
__device__ __forceinline__ void phase8(const Params& p, char* smem) {
  char* ws = p.ws;
  bf16_t(*sQ)[136] = (bf16_t(*)[136])smem;
  float(*sS)[132] = (float(*)[132])smem;
  for (int tile = blockIdx.x; tile < 128 * 16; tile += gridDim.x) {
    const int tm = tile >> 4, tn = tile & 15;
    const int h = tn >> 1, hf = tn & 1;
    float* rsq = (float*)(smem + 73728);
    if (get_tid() < 128) {
      const float4* pp = (const float4*)((const float*)(ws + OFF_SSQ) + (size_t)(tm * 128 + get_tid()) * 16);
      const float4 a = pp[0], b = pp[1], c = pp[2], d = pp[3];
      const float ss = (((a.x + a.y) + (a.z + a.w)) + ((b.x + b.y) + (b.z + b.w))) + (((c.x + c.y) + (c.z + c.w)) + ((d.x + d.y) + (d.z + d.w)));
      rsq[get_tid()] = rsqrtf(ss * (1.f / 1024.f) + 1e-6f);
    }
    f32x4 acc[4][4];
    gemm_tile_128((const bf16_t*)(ws + OFF_Z), 1024, SEQ, (const bf16_t*)(ws + OFF_WQ), 1024, 2048, 1024, tm * 128, tn * 128, smem, acc);
    const int lane = get_tid() & 63, wid = get_tid() >> 6, wr = wid >> 1, wc = wid & 1;
    const int col = lane & 15, q = lane >> 4;
    float* TOPV = (float*)(ws + OFF_TOPV);
    unsigned char* TOPI = (unsigned char*)(ws + OFF_TOPI);
#pragma unroll
    for (int i = 0; i < 4; i++) {
      const float4 rv = *(const float4*)&rsq[wr * 64 + i * 16 + q * 4];
      const float rr[4] = {rv.x, rv.y, rv.z, rv.w};
#pragma unroll
      for (int j = 0; j < 4; j++)
#pragma unroll
        for (int jj = 0; jj < 4; jj++) sS[wr * 64 + i * 16 + q * 4 + jj][wc * 64 + j * 16 + col] = acc[i][j][jj] * rr[jj];
    }
    __syncthreads();
#pragma unroll 1
    for (int ps = 0; ps < 8; ps++) {
      const int row = wid * 32 + ps * 4 + q;
      unsigned kk[8];
#pragma unroll
      for (int c = 0; c < 8; c++) {
        const int k = col + 16 * c;
        unsigned bits = __float_as_uint(sS[row][k]);
        unsigned u = bits ^ ((unsigned)((int)bits >> 31) | 0x80000000u);
        kk[c] = (u & 0xFFFFFF80u) | (unsigned)(127 - k);
      }
#define CSWAP(a, b) { unsigned hi_ = max(kk[a], kk[b]), lo_ = min(kk[a], kk[b]); kk[a] = hi_; kk[b] = lo_; }
      CSWAP(0, 1) CSWAP(2, 3) CSWAP(4, 5) CSWAP(6, 7)
      CSWAP(0, 2) CSWAP(1, 3) CSWAP(4, 6) CSWAP(5, 7)
      CSWAP(1, 2) CSWAP(5, 6)
      CSWAP(0, 4) CSWAP(1, 5) CSWAP(2, 6) CSWAP(3, 7)
      CSWAP(2, 4) CSWAP(3, 5)
      CSWAP(1, 2) CSWAP(3, 4) CSWAP(5, 6)
#undef CSWAP
      unsigned mine = 0;
#pragma unroll 1
      for (int r = 0; r < 16; r++) {
        unsigned w = kk[0];
        w = max(w, (unsigned)__builtin_amdgcn_update_dpp(0u, w, 0x128, 0xF, 0xF, false));
        w = max(w, (unsigned)__builtin_amdgcn_update_dpp(0u, w, 0x124, 0xF, 0xF, false));
        w = max(w, (unsigned)__builtin_amdgcn_update_dpp(0u, w, 0x122, 0xF, 0xF, false));
        w = max(w, (unsigned)__builtin_amdgcn_update_dpp(0u, w, 0x121, 0xF, 0xF, false));
        if (col == r) mine = w;
        const bool pop = (kk[0] == w);
        kk[0] = pop ? kk[1] : kk[0];
        kk[1] = pop ? kk[2] : kk[1];
        kk[2] = pop ? kk[3] : kk[2];
        kk[3] = pop ? kk[4] : kk[3];
        kk[4] = pop ? kk[5] : kk[4];
        kk[5] = pop ? kk[6] : kk[5];
        kk[6] = pop ? kk[7] : kk[6];
        kk[7] = pop ? 0u : kk[7];
      }
      const int idx = 127 - (int)(mine & 127u);
      const float val = sS[row][idx];
      const size_t o = (((size_t)(tm * 128 + row) * 8 + h) * 2 + hf) * 16 + col;
      TOPV[o] = val;
      TOPI[o] = (unsigned char)idx;
    }
    __syncthreads();
  }
}

__device__ const unsigned char STAIR_TAB[64] = {0, 1, 2, 3, 4, 5, 6, 7, 8, 9, 10, 11, 12, 13, 14, 15, 16, 17, 18, 19, 20, 21, 22, 23, 32, 33, 34, 35, 36, 48, 49, 50, 51, 64, 65, 66, 80, 81, 96, 97, 112, 113, 128, 144, 160, 176, 192, 208, 224, 240, 0, 0, 0, 0, 0, 0, 0, 0, 0, 0, 0, 0, 0, 0};
__device__ __forceinline__ void wave_sort_desc(float& v, int& c, int lane) {
#pragma unroll
  for (int k = 2; k <= 64; k <<= 1) {
#pragma unroll
    for (int j = k >> 1; j > 0; j >>= 1) {
      float ov = __shfl_xor(v, j, 64);
      int oc = __shfl_xor(c, j, 64);
      bool other_first = (ov > v) || (ov == v && oc < c);
      bool lower = (lane & j) == 0;
      bool asc = (lane & k) == 0;
      bool take_first = (lower == asc);
      bool take_other = (take_first == other_first);
      v = take_other ? ov : v;
      c = take_other ? oc : c;
    }
  }
}

__device__ __forceinline__ void phase9(const Params& p, char* smem) {
  char* ws = p.ws;
  const int tid = get_tid(), lane = tid & 63, wid = tid >> 6;
  int* pe = (int*)(smem + wid * 2560);
  float* pg = (float*)(smem + wid * 2560 + 512);
  float* tvl = (float*)(smem + wid * 2560 + 1024);
  unsigned char* til = (unsigned char*)(smem + wid * 2560 + 2048);
  const float* TOPV = (const float*)(ws + OFF_TOPV);
  const unsigned char* TOPI = (const unsigned char*)(ws + OFF_TOPI);
  const bf16_t* XN = (const bf16_t*)(ws + OFF_Z);
  const unsigned char* UT8 = (const unsigned char*)(ws + OFF_UT);
  const unsigned char* VT8 = UT8 + 16 * MB;
  const float* fng = p.in[25];
  const int st = STAIR_TAB[lane];
  const int sti = st >> 4, stj = st & 15;
  for (int t = blockIdx.x * 4 + wid; t < SEQ; t += gridDim.x * 4) {
    wave_lds_sync();
    {
      const char* wsl = ws;
      asm volatile("" : "+s"(wsl));
      const int l4 = 4 * (get_tid() & 63);
      *(float4*)(tvl + l4) = *(const float4*)((const float*)(wsl + OFF_TOPV) + (size_t)t * 256 + l4);
      *(unsigned*)(til + l4) = *(const unsigned*)((const unsigned char*)(wsl + OFF_TOPI) + (size_t)t * 256 + l4);
    }
    wave_lds_sync();
#pragma unroll 1
    for (int h = 0; h < 8; h++) {
      const float cvx = tvl[h * 32 + sti] + tvl[h * 32 + 16 + stj];
      const unsigned bits = __float_as_uint(cvx);
      unsigned key = ((bits ^ ((unsigned)((int)bits >> 31) | 0x80000000u)) & 0xFFFFFF00u) | (unsigned)(255 - st);
      if (lane >= 50) key = 0u;
#pragma unroll
      for (int k = 2; k <= 64; k <<= 1) {
#pragma unroll
        for (int j = k >> 1; j > 0; j >>= 1) {
          const unsigned other = (unsigned)__shfl_xor((int)key, j, 64);
          const bool take_max = (((lane & j) == 0) == ((lane & k) == 0));
          key = take_max ? max(key, other) : min(key, other);
        }
      }
      const int cc = 255 - (int)(key & 255u);
      const float cv = tvl[h * 32 + ((cc >> 4) & 15)] + tvl[h * 32 + 16 + (cc & 15)];
      float mx = __shfl(cv, 0, 64);
      float ex = (lane < 16) ? expf(cv - mx) : 0.f;
      float sm = wave_sum(ex);
      if (lane < 16) {
        const int e = (int)til[h * 32 + ((cc >> 4) & 15)] * 128 + (int)til[h * 32 + 16 + (cc & 15)];
        pe[h * 16 + lane] = e;
        pg[h * 16 + lane] = ex / sm;
      }
    }
    wave_lds_sync();
    {
      const int half = lane >> 5, ck = lane & 31;
      float xs[32];
      {
        const bf16_t* xp = XN + (size_t)t * 1024 + 32 * ck;
        float xn[32];
#pragma unroll
        for (int i = 0; i < 4; i++) {
          uint4 a = *(const uint4*)(xp + 8 * i);
          xn[8 * i + 0] = bflo(a.x); xn[8 * i + 1] = bfhi(a.x); xn[8 * i + 2] = bflo(a.y); xn[8 * i + 3] = bfhi(a.y);
          xn[8 * i + 4] = bflo(a.z); xn[8 * i + 5] = bfhi(a.z); xn[8 * i + 6] = bflo(a.w); xn[8 * i + 7] = bfhi(a.w);
        }
        float ssp = 0.f;
        if ((get_tid() & 63) < 16) ssp = ((const float*)(ws + OFF_SSQ))[(size_t)t * 16 + (get_tid() & 63)];
        const float rstd = rsqrtf(wave_sum(ssp) * (1.f / 1024.f) + 1e-6f);
#pragma unroll
        for (int j = 0; j < 32; j++) xs[j] = xn[FP6_COL(j)] * rstd;
      }
      const unsigned char* UT6 = (const unsigned char*)(ws + OFF_UT) + 16 * ck;
      const unsigned char* VT6 = UT6 + 768;
      float oacc[32];
#pragma unroll
      for (int j = 0; j < 32; j++) oacc[j] = 0.f;
#define NSL 2
      auto rows_load = [&](uint2 (&ur)[NSL][3], uint2 (&vr)[NSL][3], float (&gate)[NSL], int pp) __attribute__((always_inline)) {
#pragma unroll
        for (int k = 0; k < NSL; k++) {
          const int pi = min(pp + 2 * k + half, 127);
          const int e = pe[pi];
          gate[k] = (pp + 2 * k + half < 128) ? pg[pi] : 0.f;
          const unsigned char* up = UT6 + (size_t)e * 1536;
          const unsigned char* vp = VT6 + (size_t)e * 1536;
          const uint4 ua = *(const uint4*)up, va = *(const uint4*)vp;
          ur[k][0] = make_uint2(ua.x, ua.y); ur[k][1] = make_uint2(ua.z, ua.w); ur[k][2] = *(const uint2*)(up + 512 - 8 * ck);
          vr[k][0] = make_uint2(va.x, va.y); vr[k][1] = make_uint2(va.z, va.w); vr[k][2] = *(const uint2*)(vp + 512 - 8 * ck);
        }
      };
      auto rows_use = [&](const uint2 (&ur)[NSL][3], const uint2 (&vr)[NSL][3], const float (&gate)[NSL]) __attribute__((always_inline)) {
        float hid[NSL];
#pragma unroll
        for (int k = 0; k < NSL; k++) {
          v6u_t w = {ur[k][0].x, ur[k][0].y, ur[k][1].x, ur[k][1].y, ur[k][2].x, ur[k][2].y};
          v32f_t du = __builtin_amdgcn_cvt_scalef32_pk32_f32_fp6(w, 1.0f);
          float s0 = 0.f, s1 = 0.f;
#pragma unroll
          for (int j = 0; j < 32; j += 2) { s0 += xs[j] * du[j]; s1 += xs[j + 1] * du[j + 1]; }
          hid[k] = s0 + s1;
        }
#pragma unroll
        for (int o = 16; o > 0; o >>= 1) {
#pragma unroll
          for (int k = 0; k < NSL; k++) hid[k] += __shfl_xor(hid[k], o, 64);
        }
#pragma unroll
        for (int k = 0; k < NSL; k++) {
          const float act = gelu_tanh(hid[k] * (1.f / 64.f)) * gate[k];
          v6u_t w = {vr[k][0].x, vr[k][0].y, vr[k][1].x, vr[k][1].y, vr[k][2].x, vr[k][2].y};
          v32f_t dv = __builtin_amdgcn_cvt_scalef32_pk32_f32_fp6(w, 1.0f);
#pragma unroll
          for (int j = 0; j < 32; j++) oacc[j] += act * dv[j];
        }
      };
      {
        uint2 urA[NSL][3], vrA[NSL][3], urB[NSL][3], vrB[NSL][3];
        float gA[NSL], gB[NSL];
        rows_load(urA, vrA, gA, 0);
#pragma unroll 1
        for (int pp = 0; pp < 128; pp += 4 * NSL) {
          rows_load(urB, vrB, gB, pp + 2 * NSL);
          rows_use(urA, vrA, gA);
          if (pp + 4 * NSL < 128) rows_load(urA, vrA, gA, pp + 4 * NSL);
          rows_use(urB, vrB, gB);
        }
      }
#undef NSL
#pragma unroll
      for (int j = 0; j < 32; j++) oacc[j] += __shfl_xor(oacc[j], 32, 64);
      float hv[32];
      float ss = 0.f;
      float* hrow = p.out + (size_t)t * 1024 + 32 * ck;
      if (half == 0) {
        float on[32];
#pragma unroll
        for (int j = 0; j < 32; j++) on[FP6_COL(j)] = oacc[j] * 0.25f;
#pragma unroll
        for (int i = 0; i < 8; i++) {
          float4 v4 = *(const float4*)(hrow + 4 * i);
          hv[4 * i + 0] = v4.x + on[4 * i + 0];
          hv[4 * i + 1] = v4.y + on[4 * i + 1];
          hv[4 * i + 2] = v4.z + on[4 * i + 2];
          hv[4 * i + 3] = v4.w + on[4 * i + 3];
        }
#pragma unroll
        for (int j = 0; j < 32; j++) ss += hv[j] * hv[j];
      } else {
#pragma unroll
        for (int j = 0; j < 32; j++) hv[j] = 0.f;
      }
      ss = wave_sum(ss);
      const float inv = rsqrtf(ss * (1.f / 1024.f) + 1e-6f);
      if (half == 0) {
#pragma unroll
        for (int i = 0; i < 8; i++) {
          float4 gg = *(const float4*)(fng + 32 * ck + 4 * i);
          *(float4*)(hrow + 4 * i) = make_float4(hv[4 * i] * inv * gg.x, hv[4 * i + 1] * inv * gg.y, hv[4 * i + 2] * inv * gg.z, hv[4 * i + 3] * inv * gg.w);
        }
      }
    }
  }
}

#define XB_TMO      128
#define XB_XCNT(j)  (256  + 64 * (j))
#define XB_XSUB(j)  (1280 + 64 * (j))
#define XB_XGEN(j)  (2304 + 64 * (j))
#define XB_TOP      3328
#define XB_TOPGEN   3392
#define XCD_BAR_WORDS 3456
#define XB_SPIN_CAP (1u << 22)
__device__ __forceinline__ unsigned xb_ld(unsigned* p) { return __hip_atomic_load(p, __ATOMIC_RELAXED, __HIP_MEMORY_SCOPE_AGENT); }
__device__ __forceinline__ unsigned xb_add(unsigned* p, unsigned v) { return __hip_atomic_fetch_add(p, v, __ATOMIC_RELAXED, __HIP_MEMORY_SCOPE_AGENT); }
__device__ __forceinline__ unsigned xb_xcc_id() { return (unsigned)__builtin_amdgcn_s_getreg((3 << 11) | 20) & 0xFu; }
#define XB_SPIN(cond, bar) do { unsigned _sp = 0; while (cond) { __builtin_amdgcn_s_sleep(1); \
    if ((++_sp & 255u) == 0u) { if (xb_ld(&(bar)[XB_TMO])) break; if (_sp > XB_SPIN_CAP) { atomicAdd(&(bar)[XB_TMO], 1u); break; } } } } while (0)
struct XcdBarrier { unsigned* bar; unsigned x; volatile LAS unsigned* st; };
__device__ __forceinline__ XcdBarrier xcd_barrier_post(unsigned* bar, volatile LAS unsigned* st) {
  XcdBarrier b; b.bar = bar; b.x = xb_xcc_id(); b.st = st;
  if (threadIdx.x == 0) (void)xb_add(&bar[XB_XCNT(b.x)], 1u);
  return b;
}
__device__ __forceinline__ void xcd_barrier_complete(unsigned* bar, unsigned x, unsigned& nloc, unsigned& nx) {
  const unsigned G = gridDim.x * gridDim.y * gridDim.z;
  unsigned sum, cnt, mine, sp = 0u;
  for (;;) {
    sum = 0u; cnt = 0u; mine = 0u;
#pragma unroll
    for (unsigned j = 0; j < 16; ++j) { const unsigned c = xb_ld(&bar[XB_XCNT(j)]); sum += c; cnt += (c > 0u) ? 1u : 0u; mine = (j == x) ? c : mine; }
    if (sum == G) break;
    __builtin_amdgcn_s_sleep(1);
    if ((++sp & 255u) == 0u) { if (xb_ld(&bar[XB_TMO])) break; if (sp > XB_SPIN_CAP) { atomicAdd(&bar[XB_TMO], 1u); break; } }
  }
  nloc = mine > 0u ? mine : 1u; nx = cnt > 0u ? cnt : 1u;
}
__device__ __forceinline__ void xcd_barrier(const XcdBarrier& b) {
  asm volatile("s_waitcnt vmcnt(0)" ::: "memory");
  __syncthreads();
  if (threadIdx.x == 0) {
    unsigned* bar = b.bar;
    __builtin_amdgcn_s_waitcnt(0);
    unsigned nloc = b.st[0], nx = b.st[1];
    if (nloc == 0u) { xcd_barrier_complete(bar, b.x, nloc, nx); b.st[0] = nloc; b.st[1] = nx; }
    const unsigned old = xb_add(&bar[XB_XSUB(b.x)], 1u);
    const unsigned gen = old / nloc;
    if (old + 1u == (gen + 1u) * nloc) {
      __builtin_amdgcn_fence(__ATOMIC_RELEASE, "agent");
      asm volatile("s_waitcnt vmcnt(0)" ::: "memory");
      const unsigned og = xb_add(&bar[XB_TOP], 1u);
      const unsigned tg = og / nx;
      if (og + 1u == (tg + 1u) * nx) xb_add(&bar[XB_TOPGEN], 1u);
      else XB_SPIN(xb_ld(&bar[XB_TOPGEN]) == tg, bar);
      __builtin_amdgcn_fence(__ATOMIC_ACQUIRE, "agent");
      xb_add(&bar[XB_XGEN(b.x)], 1u);
      asm volatile("s_waitcnt vmcnt(0)" ::: "memory");
    } else {
      XB_SPIN(xb_ld(&bar[XB_XGEN(b.x)]) == gen, bar);
      __builtin_amdgcn_fence(__ATOMIC_ACQUIRE, "agent");
      asm volatile("s_waitcnt vmcnt(0)" ::: "memory");
    }
  }
  __syncthreads();
}

#define OFF_BAR (244 * MB)
__global__ void __launch_bounds__(256, 2) k_mega(Params p) {
  __shared__ __attribute__((aligned(16))) char smem[SMEM_BYTES];
  cg::grid_group grid = cg::this_grid();
  volatile LAS unsigned* xbw = (volatile LAS unsigned*)(smem + SMEM_BYTES - 16);
  if (threadIdx.x == 0) { xbw[0] = 0u; xbw[1] = 0u; xbw[2] = 0u; xbw[3] = 0u; }
  __syncthreads();
  XcdBarrier xb = xcd_barrier_post((unsigned*)(p.ws + OFF_BAR), xbw);
  if (p.ws == nullptr) grid.sync();
  phase0(p, smem); xcd_barrier(xb);
  phase1(p, smem); xcd_barrier(xb);
  phase2(p, smem); xcd_barrier(xb);
  phase4(p, smem); xcd_barrier(xb);
  phase4b(p, smem);
  __syncthreads();
  phase5(p, smem); xcd_barrier(xb);
  phase6(p, smem); xcd_barrier(xb);
  phase8(p, smem); xcd_barrier(xb);
  phase9(p, smem);
}

extern "C" void kernel_launch(void* const* d_in, const int* in_sizes, int n_in, void* d_out, int out_size,
                              void* d_ws, size_t ws_size, hipStream_t stream) {
  Params p{};
  for (int i = 0; i < 26; i++) p.in[i] = (const float*)d_in[i];
  p.out = (float*)d_out;
  p.ws = (char*)d_ws;
  static int grid_blocks = 0;
  if (!grid_blocks) {
    int dev = 0, cus = 0, per_cu = 0;
    (void)hipGetDevice(&dev);
    (void)hipDeviceGetAttribute(&cus, hipDeviceAttributeMultiprocessorCount, dev);
    (void)hipOccupancyMaxActiveBlocksPerMultiprocessor(&per_cu, k_mega, 256, 0);
    if (per_cu > 2) per_cu = 2;
    if (per_cu < 1) per_cu = 1;
    grid_blocks = cus * per_cu;
  }
  (void)hipMemsetAsync((char*)d_ws + OFF_BAR, 0, 32768, stream);
  void* args[] = {&p};
  hipError_t e = hipLaunchCooperativeKernel((void*)k_mega, dim3(grid_blocks), dim3(256), args, 0, stream);
  if (e != hipSuccess) fprintf(stderr, "cooperative launch failed: %s (grid %d)\n", hipGetErrorString(e), grid_blocks);
}
```

```cpp
#include <hip/hip_runtime.h>
#include <hip/hip_cooperative_groups.h>
#include <cstdio>
#include <cstdint>
#include <type_traits>
namespace cg = cooperative_groups;

#define LAS __attribute__((address_space(3)))
typedef unsigned short bf16_t;
using bf16x8 = __attribute__((ext_vector_type(8))) short;
using f32x4 = __attribute__((ext_vector_type(4))) float;
using u32x4 = __attribute__((ext_vector_type(4))) unsigned int;

#define SEQ 16384
#define DMODEL 1024
#define NEG_INF_F (-1e30f)
#define NPHASE 10
#define SMEM_BYTES 79872

#define MB (1024ull * 1024ull)
#define OFF_UT (0ull)
#define OFF_VT (32 * MB)
#define OFF_W (64 * MB)
#define OFF_WIN (OFF_W)
#define OFF_WGLU (OFF_WIN + 3932160ull)
#define OFF_WOUT (OFF_WGLU + 1048576ull)
#define OFF_WQ (OFF_WOUT + 2097152ull)
#define OFF_W1K (OFF_WQ + 4194304ull)
#define OFF_W1V (OFF_W1K + 524288ull)
#define OFF_W2K (OFF_W1V + 524288ull)
#define OFF_W2V (OFF_W2K + 16384ull)
#define OFF_BIASK (OFF_W2V + 16384ull)
#define OFF_BIASV (OFF_BIASK + 512ull)
#define OFF_SUBT (OFF_BIASV + 512ull)
#define OFF_LAMB (OFF_SUBT + 65536ull)
#define OFF_LAM64 (OFF_LAMB + 16384ull)
#define OFF_BBAR (OFF_LAM64 + 16384ull)
#define OFF_Z (80 * MB)
#define OFF_Q (112 * MB)
#define OFF_KV (128 * MB)
#define KV_STRIDE (4 * MB)
#define OFF_U (152 * MB)
#define OFF_MIX (184 * MB)
#define OFF_GATES (216 * MB)
#define OFF_KC (OFF_GATES + 1572864ull)
#define OFF_VC (OFF_KC + 262144ull)
#define OFF_HID (218 * MB)
#define OFF_E (219 * MB)
#define OFF_CIN (223 * MB)
#define OFF_YG (227 * MB)
#define OFF_WQB (OFF_YG)
#define OFF_SM (OFF_MIX)
#define OFF_SQ (OFF_MIX + 24 * MB)
#define OFF_CINB (OFF_CIN)
#define OFF_KT (OFF_CIN + 2 * MB)
#define OFF_UB (OFF_MIX + 8 * MB)
#define OFF_SSQ OFF_E
#define OFF_PQ (112 * MB)

struct Params {
  const float* in[26];
  float* out;
  char* ws;
};

__device__ __forceinline__ int get_tid() {
  int t = threadIdx.x;
  asm volatile("" : "+v"(t));
  return t;
}
__device__ __forceinline__ bf16_t f2bf(float f) {
  unsigned u = __float_as_uint(f);
  u += 0x7FFFu + ((u >> 16) & 1u);
  return (bf16_t)(u >> 16);
}
__device__ __forceinline__ float bf2f(bf16_t b) { return __uint_as_float(((unsigned)b) << 16); }
__device__ __forceinline__ float bflo(unsigned w) { return __uint_as_float(w << 16); }
__device__ __forceinline__ float bfhi(unsigned w) { return __uint_as_float(w & 0xFFFF0000u); }
typedef __bf16 bf16v2_t __attribute__((ext_vector_type(2)));
typedef float f32v2_t __attribute__((ext_vector_type(2)));
__device__ __forceinline__ unsigned pack2(float a, float b) {
  f32v2_t v = {a, b};
  return __builtin_bit_cast(unsigned, __builtin_convertvector(v, bf16v2_t));
}

__device__ __forceinline__ float gelu_tanh(float x) {
  const float u2 = 2.f * 0.7978845608028654f * (x + 0.044715f * x * x * x);
  return x * __builtin_amdgcn_rcpf(1.f + __builtin_amdgcn_exp2f(-1.4426950408889634f * u2));
}
__device__ __forceinline__ float sigmoid_f(float x) { return __builtin_amdgcn_rcpf(1.f + __builtin_amdgcn_exp2f(-1.4426950408889634f * x)); }

__device__ __forceinline__ float wave_sum(float v) {
#pragma unroll
  for (int o = 32; o > 0; o >>= 1) v += __shfl_xor(v, o, 64);
  return v;
}
__device__ __forceinline__ float wave_max(float v) {
#pragma unroll
  for (int o = 32; o > 0; o >>= 1) v = fmaxf(v, __shfl_xor(v, o, 64));
  return v;
}
__device__ __forceinline__ void wave_argmax(float& v, int& i) {
#pragma unroll
  for (int o = 32; o > 0; o >>= 1) {
    float ov = __shfl_xor(v, o, 64);
    int oi = __shfl_xor(i, o, 64);
    if (ov > v || (ov == v && oi < i)) { v = ov; i = oi; }
  }
}
__device__ __forceinline__ void wave_lds_sync() { asm volatile("s_waitcnt lgkmcnt(0)" ::: "memory"); }

__device__ __forceinline__ void sincos_big(float ang, float& sn, float& cs) {
  double rev = (double)ang * 0.15915494309189535;
  rev -= floor(rev);
  float fr = (float)rev;
  sn = __builtin_amdgcn_sinf(fr);
  cs = __builtin_amdgcn_cosf(fr);
}
__device__ __forceinline__ float rope_inv(int i) {
  return exp2f(-(float)i * 2.36644607f);
}

template <int BMODE = 0, bool ZERO = true>
__device__ __forceinline__ void gemm_tile_128(const bf16_t* __restrict__ A, long lda, int M,
                                              const bf16_t* __restrict__ Bt, long ldb, int N, int K,
                                              int row0, int col0, char* smem, f32x4 (&acc)[4][4]) {
  bf16_t(*sA)[72] = (bf16_t(*)[72])smem;
  bf16_t(*sB)[72] = (bf16_t(*)[72])(smem + 128 * 72 * 2);
  const int tid = get_tid(), lane = tid & 63, wid = tid >> 6;
  const int wr = wid >> 1, wc = wid & 1;
  if (ZERO) {
#pragma unroll
    for (int i = 0; i < 4; i++)
#pragma unroll
      for (int j = 0; j < 4; j++) acc[i][j] = (f32x4){0.f, 0.f, 0.f, 0.f};
  }
  const int lr = tid >> 3;
  const int lc = (tid & 7) * 8;
  u32x4 ra[4], rb[4];
  const u32x4 z4 = {0u, 0u, 0u, 0u};
  const bf16_t* pa[4];
  const bf16_t* pb[4];
  bool va[4], vb[4];
  int klim[4];
#pragma unroll
  for (int i = 0; i < 4; i++) {
    int r = lr + 32 * i;
    va[i] = (row0 + r < M);
    vb[i] = (col0 + r < N);
    pa[i] = A + (long)min(row0 + r, M - 1) * lda + lc;
    if (BMODE == 0) {
      pb[i] = Bt + (long)min(col0 + r, N - 1) * ldb + lc;
      klim[i] = 0;
    } else {
      const int n = col0 + r, t = n >> 4, ch = n & 15;
      pb[i] = Bt + ((long)(t - (lc >> 4)) * 16 + ch) * 16 + (lc & 15);
      klim[i] = (t + 1) * 16 - lc;
    }
  }
  u32x4 rc[4], rd[4];
  auto gload = [&](u32x4 (&xa)[4], u32x4 (&xb)[4], int k) __attribute__((always_inline)) {
#pragma unroll
    for (int i = 0; i < 4; i++) {
      u32x4 x = *(const u32x4*)(pa[i] + k);
      xa[i] = va[i] ? x : z4;
      if (BMODE == 0) {
        u32x4 y = *(const u32x4*)(pb[i] + k);
        xb[i] = vb[i] ? y : z4;
      } else {
        const bool ok = k < klim[i];
        u32x4 y = *(const u32x4*)(ok ? pb[i] - 16 * (long)k : Bt);
        xb[i] = ok ? y : z4;
      }
    }
  };
  auto lstore = [&](const u32x4 (&xa)[4], const u32x4 (&xb)[4], int buf) __attribute__((always_inline)) {
    bf16_t(*nA)[72] = (bf16_t(*)[72])(smem + buf * 36864);
    bf16_t(*nB)[72] = (bf16_t(*)[72])(smem + buf * 36864 + 18432);
#pragma unroll
    for (int i = 0; i < 4; i++) {
      int r = lr + 32 * i;
      *(u32x4*)&nA[r][lc] = xa[i];
      *(u32x4*)&nB[r][lc] = xb[i];
    }
  };
  auto compute = [&](int buf) __attribute__((always_inline)) {
    bf16_t(*cA)[72] = (bf16_t(*)[72])(smem + buf * 36864);
    bf16_t(*cB)[72] = (bf16_t(*)[72])(smem + buf * 36864 + 18432);
#pragma unroll
    for (int ks = 0; ks < 2; ks++) {
      bf16x8 af[4], bfr[4];
#pragma unroll
      for (int i = 0; i < 4; i++) af[i] = *(const bf16x8*)&cA[wr * 64 + i * 16 + (lane & 15)][ks * 32 + (lane >> 4) * 8];
#pragma unroll
      for (int j = 0; j < 4; j++) bfr[j] = *(const bf16x8*)&cB[wc * 64 + j * 16 + (lane & 15)][ks * 32 + (lane >> 4) * 8];
#pragma unroll
      for (int i = 0; i < 4; i++)
#pragma unroll
        for (int j = 0; j < 4; j++) acc[i][j] = __builtin_amdgcn_mfma_f32_16x16x32_bf16(af[i], bfr[j], acc[i][j], 0, 0, 0);
    }
  };
  gload(ra, rb, 0);
  if (64 < K) gload(rc, rd, 64);
  __syncthreads();
  lstore(ra, rb, 0);
  if (128 < K) gload(ra, rb, 128);
  for (int k0 = 0; k0 < K; k0 += 128) {
    __syncthreads();
    if (k0 + 64 < K) lstore(rc, rd, 1);
    if (k0 + 192 < K) gload(rc, rd, k0 + 192);
    compute(0);
    if (k0 + 64 < K) {
      __syncthreads();
      if (k0 + 128 < K) lstore(ra, rb, 0);
      if (k0 + 256 < K) gload(ra, rb, k0 + 256);
      compute(1);
    }
  }
  __syncthreads();
}

#define EPI_LD 68
__device__ __forceinline__ float* stage_acc(const f32x4 (&acc)[4][4], char* smem) {
  const int lane = get_tid() & 63, wid = get_tid() >> 6;
  float* t = (float*)(smem + wid * (64 * EPI_LD * 4));
  const int q = lane >> 4, c = lane & 15;
#pragma unroll
  for (int i = 0; i < 4; i++)
#pragma unroll
    for (int j = 0; j < 4; j++)
#pragma unroll
      for (int jj = 0; jj < 4; jj++) t[(i * 16 + q * 4 + jj) * EPI_LD + j * 16 + c] = acc[i][j][jj];
  wave_lds_sync();
  return t;
}

__device__ __forceinline__ void transpose_job(const float* __restrict__ src, int Ksrc, int Nsrc, bf16_t* __restrict__ dst, int Ndst,
                              int perm, int tile, char* smem) {
  float(*t)[65] = (float(*)[65])smem;
  const int tiles_k = Ksrc / 64;
  const int tn = tile / tiles_k, tk = tile % tiles_k;
  const int tid = get_tid();
  __syncthreads();
  for (int e = tid; e < 64 * 64; e += 256) {
    int kk = e >> 6, nn = e & 63;
    int n = tn * 64 + nn;
    int oc;
    if (perm == 1) {
      oc = (n < 1280) ? n : (n < 1792 ? 1304 + (n - 1280) : (n < 1816 ? 1280 + (n - 1792) : -1));
    } else if (perm == 2) {
      int b64 = n >> 6, w = n & 63;
      oc = (w < 32) ? (32 * b64 + w) : (512 + 32 * b64 + (w - 32));
    } else {
      oc = (n < Nsrc) ? n : -1;
    }
    float v = 0.f;
    if (oc >= 0) v = src[(size_t)(tk * 64 + kk) * Nsrc + oc];
    t[kk][nn] = v;
  }
  __syncthreads();
  for (int e = tid; e < 64 * 64; e += 256) {
    int nn = e >> 6, kk = e & 63;
    dst[(size_t)(tn * 64 + nn) * Ksrc + tk * 64 + kk] = f2bf(t[kk][nn]);
  }
}

__device__ __forceinline__ void phase0(const Params& p, char* smem) {
  const int tid = get_tid(), lane = tid & 63, wid = tid >> 6;
  const int gw = blockIdx.x * 4 + wid, nw = gridDim.x * 4;
  char* ws = p.ws;
  {
    const float* x = p.in[0];
    const float* g = p.in[1];
    bf16_t* z = (bf16_t*)(ws + OFF_Z);
    for (int r = gw; r < SEQ; r += nw) {
      const float4* src = (const float4*)(x + (size_t)r * 1024);
      float4 v[4];
      float ss = 0.f;
#pragma unroll
      for (int i = 0; i < 4; i++) {
        v[i] = src[lane + 64 * i];
        ss += v[i].x * v[i].x + v[i].y * v[i].y + v[i].z * v[i].z + v[i].w * v[i].w;
      }
      ss = wave_sum(ss);
      float inv = rsqrtf(ss * (1.f / 1024.f) + 1e-6f);
#pragma unroll
      for (int i = 0; i < 4; i++) {
        float4 gg = ((const float4*)g)[lane + 64 * i];
        uint2 o;
        o.x = pack2(v[i].x * inv * gg.x, v[i].y * inv * gg.y);
        o.y = pack2(v[i].z * inv * gg.z, v[i].w * inv * gg.w);
        *(uint2*)(z + (size_t)r * 1024 + (lane + 64 * i) * 4) = o;
      }
    }
  }
  {
    for (int j = blockIdx.x; j < 480; j += gridDim.x) transpose_job(p.in[2], 1024, 1816, (bf16_t*)(ws + OFF_WIN), 1920, 1, j, smem);
  }
  {
    const float4* src = (const float4*)p.in[20];
    uint2* dst = (uint2*)(ws + OFF_WQB);
    for (int i = blockIdx.x * 256 + tid; i < 1024 * 2048 / 4; i += gridDim.x * 256) {
      const float4 v = src[i];
      dst[i] = make_uint2(pack2(v.x, v.y), pack2(v.z, v.w));
    }
  }
  {
    bf16_t* dst = (bf16_t*)(ws + OFF_SUBT);
    for (int i = blockIdx.x * 256 + tid; i < 2 * 16384; i += gridDim.x * 256) {
      float v = (i < 16384) ? p.in[21][i] : p.in[22][i - 16384];
      dst[i] = f2bf(v);
    }
  }
  {
    bf16_t* SM = (bf16_t*)(ws + OFF_SM);
    for (int idx = blockIdx.x * 256 + tid; idx < 2048 * 64; idx += gridDim.x * 256) {
      const int gs = idx >> 6, t = idx & 63, g = gs >> 6, sidx = gs & 63;
      const float dt = expf(p.in[11][g]);
      const float lr = p.in[9][gs], li = p.in[10][gs];
      const float ang = li * dt;
      float sn, cs;
      sincos_big(ang, sn, cs);
      const float em1 = expm1f(lr * dt);
      const float mag = em1 + 1.f;
      float sh, ch;
      sincos_big(0.5f * ang, sh, ch);
      const float a = em1 * cs - 2.f * sh * sh;
      const float b = mag * sn;
      const float den = lr * lr + li * li;
      const float cr = (a * lr + b * li) / den;
      const float ci = (b * lr - a * li) / den;
      const float pw = (float)(63 - t);
      float snp, csp;
      sincos_big(pw * ang, snp, csp);
      const float mp = expf(pw * lr * dt);
      const float fx = mp * (csp * cr - snp * ci), fy = mp * (csp * ci + snp * cr);
      const float* bre = p.in[12] + (size_t)gs * 16;
      const float* bim = p.in[13] + (size_t)gs * 16;
      unsigned wre[8], wim[8];
#pragma unroll
      for (int c = 0; c < 8; c++) {
        const float xr0 = bre[2 * c], xi0 = bim[2 * c], xr1 = bre[2 * c + 1], xi1 = bim[2 * c + 1];
        wre[c] = pack2(fx * xr0 - fy * xi0, fx * xr1 - fy * xi1);
        wim[c] = pack2(fx * xi0 + fy * xr0, fx * xi1 + fy * xr1);
      }
      bf16_t* dre = SM + ((size_t)(g * 128 + sidx)) * 1024 + t * 16;
      bf16_t* dim = dre + (size_t)64 * 1024;
      *(uint4*)dre = make_uint4(wre[0], wre[1], wre[2], wre[3]);
      *(uint4*)(dre + 8) = make_uint4(wre[4], wre[5], wre[6], wre[7]);
      *(uint4*)dim = make_uint4(wim[0], wim[1], wim[2], wim[3]);
      *(uint4*)(dim + 8) = make_uint4(wim[4], wim[5], wim[6], wim[7]);
    }
  }
  {
    for (int gt = (((int)blockIdx.x + (int)gridDim.x - (256 % (int)gridDim.x)) % (int)gridDim.x) * 256 + tid; gt < 2048; gt += (int)gridDim.x * 256) {
      const int g = gt >> 6;
      const float dt = expf(p.in[11][g]);
      const float lr = p.in[9][gt], li = p.in[10][gt];
      float sn64, cs64;
      sincos_big(64.f * li * dt, sn64, cs64);
      const float m64 = expf(64.f * lr * dt);
      ((float2*)(ws + OFF_LAM64))[gt] = make_float2(m64 * cs64, m64 * sn64);
    }
  }
}

__device__ __forceinline__ void side_jobs(const Params& p, char* smem, int b0, int nb) {
  const int tid = get_tid(), lane = tid & 63, wid = tid >> 6;
  char* ws = p.ws;
  for (int j = b0; j < 132; j += nb) {
    if (j < 64) transpose_job(p.in[4], 2048, 128, (bf16_t*)(ws + OFF_W1K), 128, 0, j, smem);
    else if (j < 128) transpose_job(p.in[7], 2048, 128, (bf16_t*)(ws + OFF_W1V), 128, 0, j - 64, smem);
    else if (j < 130) transpose_job(p.in[5], 128, 64, (bf16_t*)(ws + OFF_W2K), 64, 0, j - 128, smem);
    else transpose_job(p.in[8], 128, 64, (bf16_t*)(ws + OFF_W2V), 64, 0, j - 130, smem);
  }
  {
    for (int o8 = b0 * 4 + wid; o8 < 32; o8 += nb * 4) {
      const int kv = o8 >> 4, j0 = (o8 & 15) * 8;
      const float* pe = kv ? p.in[6] : p.in[3];
      const float* w1 = kv ? p.in[7] : p.in[4];
      float a[8];
#pragma unroll
      for (int c = 0; c < 8; c++) a[c] = 0.f;
      for (int i = lane; i < 2048; i += 64) {
        const float pv = pe[i];
        const float4 w0 = *(const float4*)(w1 + (size_t)i * 128 + j0), w4 = *(const float4*)(w1 + (size_t)i * 128 + j0 + 4);
        a[0] += pv * w0.x; a[1] += pv * w0.y; a[2] += pv * w0.z; a[3] += pv * w0.w;
        a[4] += pv * w4.x; a[5] += pv * w4.y; a[6] += pv * w4.z; a[7] += pv * w4.w;
      }
#pragma unroll
      for (int c = 0; c < 8; c++) a[c] = wave_sum(a[c]);
      if (lane == 0) {
        float* dst = (float*)(ws + (kv ? OFF_BIASV : OFF_BIASK)) + j0;
        *(float4*)dst = make_float4(a[0], a[1], a[2], a[3]);
        *(float4*)(dst + 4) = make_float4(a[4], a[5], a[6], a[7]);
      }
    }
  }
}

__device__ __forceinline__ void phase1(const Params& p, char* smem) {
  char* ws = p.ws;
  const bf16_t* Z = (const bf16_t*)(ws + OFF_Z);
  const bf16_t* W = (const bf16_t*)(ws + OFF_WIN);
  bf16_t* Q = (bf16_t*)(ws + OFF_Q);
  float* GATES = (float*)(ws + OFF_GATES);
  const int lane = get_tid() & 63, wid = get_tid() >> 6, wr = wid >> 1, wc = wid & 1;
  for (int tile = blockIdx.x; tile < 128 * 15; tile += gridDim.x) {
    const int tm = tile / 15, tn = tile % 15;
    f32x4 acc[4][4];
    gemm_tile_128(Z, 1024, SEQ, W, 1024, 1920, 1024, tm * 128, tn * 128, smem, acc);
    const int sp = tn * 2 + wc;
    const int prow0 = tm * 128 + wr * 64;
    if (sp == 14 || sp == 15) {
      unsigned char* dst = (unsigned char*)(ws + OFF_KV + 3 * KV_STRIDE);
      const int hd = sp - 14;
#pragma unroll
      for (int j = 0; j < 4; j++) {
        const int d = j * 16 + (lane & 15);
#pragma unroll
        for (int i = 0; i < 4; i++) {
          const int pos0 = prow0 + i * 16 + (lane >> 4) * 4;
          int w = __builtin_amdgcn_cvt_pk_fp8_f32(acc[i][j][0] * 8.f, acc[i][j][1] * 8.f, 0, false);
          w = __builtin_amdgcn_cvt_pk_fp8_f32(acc[i][j][2] * 8.f, acc[i][j][3] * 8.f, w, true);
          *(int*)(dst + (((size_t)hd * 256 + (pos0 >> 6)) * 64 + d) * 64 + (pos0 & 63)) = w;
        }
      }
    } else if (sp == 18 || sp == 19) {
      const int hd = sp - 18;
#pragma unroll
      for (int j = 0; j < 4; j++) {
        const int d = j * 16 + (lane & 15);
        bf16_t* dst = (bf16_t*)(ws + OFF_KV + 5 * KV_STRIDE) + ((size_t)hd * 64 + d) * SEQ;
#pragma unroll
        for (int i = 0; i < 4; i++) {
          const int pos0 = prow0 + i * 16 + (lane >> 4) * 4;
          uint2 w;
          w.x = pack2(acc[i][j][0], acc[i][j][1]);
          w.y = pack2(acc[i][j][2], acc[i][j][3]);
          *(uint2*)(dst + pos0) = w;
        }
      }
    }
    {
      const float* t = stage_acc(acc, smem);
      const int rs = lane >> 3, ch = lane & 7;
      const bool is_q = sp < 8;
      const bool ropes = is_q || sp == 12 || sp == 13 || sp == 16 || sp == 17;
      const bool rowsec = (sp <= 13) || sp == 16 || sp == 17 || (sp >= 20 && sp <= 28);
      if (rowsec) {
#pragma unroll 2
        for (int it = 0; it < 8; it++) {
          const int r = it * 8 + rs;
          const int pos = prow0 + r;
          const float* tr = t + r * EPI_LD + 8 * ch;
          float4 a0 = *(const float4*)tr, a1 = *(const float4*)(tr + 4);
          float v[8] = {a0.x, a0.y, a0.z, a0.w, a1.x, a1.y, a1.z, a1.w};
          if (ropes && ch < 2) {
            const float* tp = t + r * EPI_LD + 8 * (ch ^ 1);
            float4 b0 = *(const float4*)tp, b1 = *(const float4*)(tp + 4);
            const float pv[8] = {b0.x, b0.y, b0.z, b0.w, b1.x, b1.y, b1.z, b1.w};
            const float sgn = (ch == 0) ? -1.f : 1.f;
#pragma unroll
            for (int i = 0; i < 8; i++) {
              float sn, cs;
              sincos_big((float)pos * rope_inv(i), sn, cs);
              v[i] = v[i] * cs + sgn * pv[i] * sn;
            }
          }
          if (is_q) {
            uint4 w;
            w.x = pack2(v[0] * 0.125f, v[1] * 0.125f); w.y = pack2(v[2] * 0.125f, v[3] * 0.125f);
            w.z = pack2(v[4] * 0.125f, v[5] * 0.125f); w.w = pack2(v[6] * 0.125f, v[7] * 0.125f);
            *(uint4*)(Q + ((size_t)pos * 8 + sp) * 64 + 8 * ch) = w;
          } else if (sp == 12 || sp == 13) {
            int w0 = __builtin_amdgcn_cvt_pk_fp8_f32(v[0] * 8.f, v[1] * 8.f, 0, false);
            w0 = __builtin_amdgcn_cvt_pk_fp8_f32(v[2] * 8.f, v[3] * 8.f, w0, true);
            int w1 = __builtin_amdgcn_cvt_pk_fp8_f32(v[4] * 8.f, v[5] * 8.f, 0, false);
            w1 = __builtin_amdgcn_cvt_pk_fp8_f32(v[6] * 8.f, v[7] * 8.f, w1, true);
            unsigned char* dst8 = (unsigned char*)(ws + OFF_KV + 2 * KV_STRIDE);
            *(uint2*)(dst8 + ((size_t)(sp - 12) * SEQ + pos) * 64 + 8 * ch) = make_uint2((unsigned)w0, (unsigned)w1);
          } else if (sp <= 17) {
            const int sec = (sp >= 16) ? 4 : ((sp - 8) >> 1);
            const int g = sp & 1;
            uint4 w;
            w.x = pack2(v[0], v[1]); w.y = pack2(v[2], v[3]); w.z = pack2(v[4], v[5]); w.w = pack2(v[6], v[7]);
            bf16_t* dst = (bf16_t*)(ws + OFF_KV + (size_t)sec * KV_STRIDE);
            *(uint4*)(dst + ((size_t)g * SEQ + pos) * 64 + 8 * ch) = w;
          } else if (sp <= 27) {
            {
              const int ug = (sp - 20) * 4 + (ch >> 1);
              uint4 w;
              w.x = pack2(v[0], v[1]); w.y = pack2(v[2], v[3]); w.z = pack2(v[4], v[5]); w.w = pack2(v[6], v[7]);
              *(uint4*)((bf16_t*)(ws + OFF_UB) + ((size_t)(ug * 256 + (pos >> 6)) * 64 + (pos & 63)) * 16 + (ch & 1) * 8) = w;
            }
          } else if (ch < 3) {
            float* dst = GATES + (size_t)pos * 24 + 8 * ch;
            *(float4*)dst = make_float4(sigmoid_f(v[0]), sigmoid_f(v[1]), sigmoid_f(v[2]), sigmoid_f(v[3]));
            *(float4*)(dst + 4) = make_float4(sigmoid_f(v[4]), sigmoid_f(v[5]), sigmoid_f(v[6]), sigmoid_f(v[7]));
          }
        }
      }
      __syncthreads();
    }
  }
  {
    const int G = (int)gridDim.x;
    const int rounds = (128 * 15 + G - 1) / G;
    const int idle_first = 128 * 15 - (rounds - 1) * G;
    int nb = G - idle_first, b0 = (int)blockIdx.x - idle_first;
    if (nb <= 0) { nb = G; b0 = (int)blockIdx.x; }
    if (b0 >= 0) side_jobs(p, smem, b0, nb);
  }
}


#define OFF_WQ_SSM3 (244 * MB + 16384 + 2048)
typedef float v32f_t __attribute__((ext_vector_type(32)));
typedef float v16f_t __attribute__((ext_vector_type(16)));
typedef unsigned v6u_t __attribute__((ext_vector_type(6)));
#ifndef FP6_INTERLEAVED
#define FP6_INTERLEAVED 1
#endif
#define FP6_COL(j) (FP6_INTERLEAVED ? ((((j) & 1) << 4) | ((j) >> 1)) : (j))
__device__ __forceinline__ void convert_item(const Params& p, int item) {
  char* ws = p.ws;
  const int tid = get_tid();
  {
    const int tb = item >> 7;
    const float4* src = (const float4*)(tb ? p.in[24] : p.in[23]);
    unsigned char* dst = (unsigned char*)(ws + OFF_UT);
    const float sc = tb ? 4.f : 64.f;
    const float cl = tb ? 6.f : 7.5f;
    const size_t c0 = (size_t)(item & 127) * 4096 + tid;
#pragma unroll 2
    for (size_t c = c0; c < c0 + 4096; c += 256) {
      v16f_t x, y;
#pragma unroll
      for (int i = 0; i < 4; i++) {
        float4 a = src[c * 8 + i], b2 = src[c * 8 + 4 + i];
        x[4 * i + 0] = fminf(fmaxf(a.x * sc, -cl), cl);
        x[4 * i + 1] = fminf(fmaxf(a.y * sc, -cl), cl);
        x[4 * i + 2] = fminf(fmaxf(a.z * sc, -cl), cl);
        x[4 * i + 3] = fminf(fmaxf(a.w * sc, -cl), cl);
        y[4 * i + 0] = fminf(fmaxf(b2.x * sc, -cl), cl);
        y[4 * i + 1] = fminf(fmaxf(b2.y * sc, -cl), cl);
        y[4 * i + 2] = fminf(fmaxf(b2.z * sc, -cl), cl);
        y[4 * i + 3] = fminf(fmaxf(b2.w * sc, -cl), cl);
      }
      const size_t row = c >> 5, ckk = c & 31;
      unsigned char* rb = dst + row * 1280;
      if (tb == 0) {
        v6u_t w = __builtin_amdgcn_cvt_scalef32_2xpk16_fp6_f32(x, y, 1.0f);
        *(uint4*)(rb + 16 * ckk) = make_uint4(w[0], w[1], w[2], w[3]);
        *(uint2*)(rb + 512 + 8 * ckk) = make_uint2(w[4], w[5]);
      } else {
        unsigned w4[4];
#pragma unroll
        for (int d = 0; d < 4; d++) {
          unsigned w = 0u;
          float v8[8];
#pragma unroll
          for (int e = 0; e < 8; e++) v8[e] = (d < 2) ? x[8 * d + e] : y[8 * (d - 2) + e];
          w = __builtin_amdgcn_cvt_scalef32_pk_fp4_f32(w, v8[0], v8[1], 1.0f, 0);
          w = __builtin_amdgcn_cvt_scalef32_pk_fp4_f32(w, v8[2], v8[3], 1.0f, 1);
          w = __builtin_amdgcn_cvt_scalef32_pk_fp4_f32(w, v8[4], v8[5], 1.0f, 2);
          w = __builtin_amdgcn_cvt_scalef32_pk_fp4_f32(w, v8[6], v8[7], 1.0f, 3);
          w4[d] = w;
        }
        *(uint4*)(rb + 768 + 16 * ckk) = make_uint4(w4[0], w4[1], w4[2], w4[3]);
      }
    }
  }
}

__device__ __forceinline__ void dep_wait(unsigned* cnt, unsigned target) {
  if (get_tid() == 0) {
    unsigned sp = 0;
    while (__hip_atomic_load(cnt, __ATOMIC_RELAXED, __HIP_MEMORY_SCOPE_AGENT) < target) {
      __builtin_amdgcn_s_sleep(2);
      if (++sp > (1u << 20)) break;
    }
    __builtin_amdgcn_fence(__ATOMIC_ACQUIRE, "agent");
    asm volatile("s_waitcnt vmcnt(0)" ::: "memory");
  }
  __syncthreads();
}
__device__ __forceinline__ void dep_publish(unsigned* cnt) {
  asm volatile("s_waitcnt vmcnt(0)" ::: "memory");
  __syncthreads();
  if (get_tid() == 0) {
    __builtin_amdgcn_fence(__ATOMIC_RELEASE, "agent");
    asm volatile("s_waitcnt vmcnt(0)" ::: "memory");
    (void)__hip_atomic_fetch_add(cnt, 1u, __ATOMIC_RELAXED, __HIP_MEMORY_SCOPE_AGENT);
  }
}

__device__ __forceinline__ void phase3_task(const Params& p, char* smem, int task) {
  char* ws = p.ws;
  const int lane = get_tid() & 63, wid = get_tid() >> 6, wr = wid >> 1, wc = wid & 1;
  {
    if (task < 32) {
      const int prob = task >> 3, tm = task & 7;
      const int kv = prob >> 1, g = prob & 1;
      const bf16_t* A = (const bf16_t*)(ws + OFF_HID) + (size_t)prob * 1024 * 128;
      const bf16_t* Bt = (const bf16_t*)(ws + (kv ? OFF_W2V : OFF_W2K));
      bf16_t* dst = (bf16_t*)(ws + (kv ? OFF_VC : OFF_KC)) + (size_t)g * 1024 * 64;
      f32x4 acc[4][4];
      gemm_tile_128(A, 128, 1023, Bt, 128, 64, 128, tm * 128, 0, smem, acc);
#pragma unroll
      for (int j = 0; j < 4; j++) {
        const int col = wc * 64 + j * 16 + (lane & 15);
        const bool rope = (kv == 0) && (col < 16);
        const float inv = rope_inv(col & 7);
#pragma unroll
        for (int i = 0; i < 4; i++)
#pragma unroll
          for (int jj = 0; jj < 4; jj++) {
            int row = tm * 128 + wr * 64 + i * 16 + (lane >> 4) * 4 + jj;
            float x = acc[i][j][jj];
            float partner = __shfl_xor(x, 8, 64);
            if (rope) {
              float ang = (float)(row * 16 + 31) * inv;
              float sn, cs;
              sincos_big(ang, sn, cs);
              x = (col < 8) ? (x * cs - partner * sn) : (x * cs + partner * sn);
            }
            if (kv == 0 && row < 1023 && col < 64) dst[(size_t)row * 64 + col] = f2bf(x);
          }
        if (kv == 1 && col < 64) {
#pragma unroll
          for (int i = 0; i < 4; i++) {
            const int row0 = tm * 128 + wr * 64 + i * 16 + (lane >> 4) * 4;
            uint2 w;
            w.x = pack2(acc[i][j][0], acc[i][j][1]);
            w.y = pack2(acc[i][j][2], acc[i][j][3]);
            *(uint2*)(dst + (size_t)col * 1024 + row0) = w;
          }
        }
      }
    } else {
      const int g = task - 32, pp = get_tid() & 63, sg = get_tid() >> 6;
      const float2 l64 = ((const float2*)(ws + OFF_LAM64))[g * 64 + pp];
      const float2* E = (const float2*)(ws + OFF_E) + ((size_t)g * 256 + sg * 64) * 64 + pp;
      bf16_t* CINB = (bf16_t*)(ws + OFF_CINB) + ((size_t)g * 256 + sg * 64) * 128 + pp;
      float2 e[64];
#pragma unroll
      for (int k = 0; k < 64; k++) e[k] = E[(size_t)k * 64];
      float2 t = make_float2(0.f, 0.f);
#pragma unroll
      for (int k = 0; k < 64; k++) {
        float nr = l64.x * t.x - l64.y * t.y + e[k].x;
        float ni = l64.x * t.y + l64.y * t.x + e[k].y;
        t.x = nr;
        t.y = ni;
      }
      float2* sh = (float2*)smem;
      sh[sg * 64 + pp] = t;
      float2 P = l64;
#pragma unroll
      for (int k = 0; k < 6; k++) {
        float nr = P.x * P.x - P.y * P.y;
        float ni = 2.f * P.x * P.y;
        P.x = nr;
        P.y = ni;
      }
      __syncthreads();
      float2 carry = make_float2(0.f, 0.f);
#pragma unroll
      for (int j = 0; j < 3; j++) {
        const float2 tj = sh[j * 64 + pp];
        float nr = P.x * carry.x - P.y * carry.y + tj.x;
        float ni = P.x * carry.y + P.y * carry.x + tj.y;
        if (j < sg) {
          carry.x = nr;
          carry.y = ni;
        }
      }
#pragma unroll
      for (int k = 0; k < 64; k++) {
        CINB[(size_t)k * 128] = f2bf(carry.x);
        CINB[(size_t)k * 128 + 64] = f2bf(carry.y);
        float nr = l64.x * carry.x - l64.y * carry.y + e[k].x;
        float ni = l64.x * carry.y + l64.y * carry.x + e[k].y;
        carry.x = nr;
        carry.y = ni;
      }
      __syncthreads();
    }
  }
}

__device__ __forceinline__ void s5_operator_item(const Params& p, char* smem, int item) {
  char* ws = p.ws;
  const int lane = get_tid() & 63, wid = get_tid() >> 6;
  const int g = item >> 4, d = (item & 15) * 4 + wid;
  float2* Cs = (float2*)smem;
  float2* Gs = (float2*)(smem + 8448 + wid * 8704);
  __syncthreads();
  for (int e = get_tid(); e < 1024; e += 256) Cs[(e >> 6) * 65 + (e & 63)] = make_float2(p.in[14][g * 1024 + e], p.in[15][g * 1024 + e]);
  float2 l1;
  {
    const int gs = g * 64 + lane;
    const float dt = expf(p.in[11][g]);
    const float lr = p.in[9][gs], li = p.in[10][gs];
    const float ang = li * dt;
    float sn, cs;
    sincos_big(ang, sn, cs);
    const float em1 = expm1f(lr * dt);
    const float mag = em1 + 1.f;
    float sh, chh;
    sincos_big(0.5f * ang, sh, chh);
    const float a = em1 * cs - 2.f * sh * sh;
    const float b = mag * sn;
    const float den = lr * lr + li * li;
    const float cr = (a * lr + b * li) / den;
    const float ci = (b * lr - a * li) / den;
    const float pw = (float)d;
    float snd, csd;
    sincos_big(pw * ang, snd, csd);
    const float md = expf(pw * lr * dt);
    const float ldx = md * csd, ldy = md * snd;
    const float fx = ldx * cr - ldy * ci, fy = ldx * ci + ldy * cr;
    l1 = make_float2(ldx * (mag * cs) - ldy * (mag * sn), ldx * (mag * sn) + ldy * (mag * cs));
    const float* bre = p.in[12] + (size_t)gs * 16;
    const float* bim = p.in[13] + (size_t)gs * 16;
#pragma unroll
    for (int c = 0; c < 16; c++) {
      const float xr = bre[c], xi = bim[c];
      Gs[lane * 17 + c] = make_float2(fx * xr - fy * xi, fx * xi + fy * xr);
    }
  }
  __syncthreads();
  {
    bf16_t* Q = (bf16_t*)(ws + OFF_SQ) + ((size_t)g * 1024 + d * 16) * 128;
#pragma unroll 4
    for (int ch = 0; ch < 16; ch++) {
      const float2 cv = Cs[ch * 65 + lane];
      Q[ch * 128 + lane] = f2bf(cv.x * l1.x - cv.y * l1.y);
      Q[ch * 128 + 64 + lane] = f2bf(-(cv.x * l1.y + cv.y * l1.x));
    }
  }
  {
    const int ch = lane >> 2, c4 = (lane & 3) * 4;
    float k0 = 0.f, k1 = 0.f, k2 = 0.f, k3 = 0.f;
#pragma unroll 4
    for (int sidx = 0; sidx < 64; sidx++) {
      const float2 cv = Cs[ch * 65 + sidx];
      const float2 g0 = Gs[sidx * 17 + c4], g1 = Gs[sidx * 17 + c4 + 1], g2 = Gs[sidx * 17 + c4 + 2], g3 = Gs[sidx * 17 + c4 + 3];
      k0 += cv.x * g0.x - cv.y * g0.y;
      k1 += cv.x * g1.x - cv.y * g1.y;
      k2 += cv.x * g2.x - cv.y * g2.y;
      k3 += cv.x * g3.x - cv.y * g3.y;
    }
    bf16_t* KT = (bf16_t*)(ws + OFF_KT) + (((size_t)g * 64 + d) * 16 + ch) * 16 + c4;
    *(uint2*)KT = make_uint2(pack2(k0, k1), pack2(k2, k3));
  }
}
__device__ __forceinline__ void s5_output_tile(const Params& p, char* smem, int item) {
  char* ws = p.ws;
  const int j = 7 - (item >> 6), g = (item & 63) >> 1, m = item & 1;
  f32x4 acc[4][4];
  gemm_tile_128<1, true>((const bf16_t*)(ws + OFF_UB) + (size_t)g * 256 * 1024, 1024, 256, (const bf16_t*)(ws + OFF_KT) + (size_t)g * 64 * 256, 0,
                         1024, 128 * (j + 1), m * 128, j * 128, smem, acc);
  gemm_tile_128<0, false>((const bf16_t*)(ws + OFF_CINB) + (size_t)g * 256 * 128, 128, 256, (const bf16_t*)(ws + OFF_SQ) + (size_t)g * 1024 * 128, 128,
                          1024, 128, m * 128, j * 128, smem, acc);
  const int lane = get_tid() & 63, wid = get_tid() >> 6, wr = wid >> 1, wc = wid & 1;
  const int ch = lane & 15;
  const float dsk = p.in[16][g * 16 + ch];
  const bf16_t* UBg = (const bf16_t*)(ws + OFF_UB) + (size_t)g * 256 * 1024;
  bf16_t* YG = (bf16_t*)(ws + OFF_YG);
#pragma unroll
  for (int i = 0; i < 4; i++)
#pragma unroll
    for (int jj = 0; jj < 4; jj++) {
      const int chunk = m * 128 + wr * 64 + i * 16 + (lane >> 4) * 4 + jj;
#pragma unroll
      for (int jq = 0; jq < 4; jq++) {
        const int t = 8 * j + wc * 4 + jq;
        const float uv = bf2f(UBg[((size_t)chunk * 64 + t) * 16 + ch]);
        YG[((size_t)chunk * 64 + t) * 512 + g * 16 + ch] = f2bf(gelu_tanh(acc[i][jq][jj] + dsk * uv));
      }
    }
}

template <int MODE>
__device__ __forceinline__ void attn_tile_task(const Params& p, int tt, int g, float* impw);
__device__ __forceinline__ void phase2(const Params& p, char* smem) {
  char* ws = p.ws;
  {
    const int G = (int)gridDim.x;
    const int rank = ((G - 33 - (int)blockIdx.x) % G + G) % G;
    const int lane = get_tid() & 63, wid = get_tid() >> 6, wr = wid >> 1, wc = wid & 1;
    for (int et = rank; et < 64; et += G) {
      const int g = et >> 1, half = et & 1;
      f32x4 acc[4][4];
      gemm_tile_128((const bf16_t*)(ws + OFF_SM) + (size_t)g * 128 * 1024, 1024, 128, (const bf16_t*)(ws + OFF_UB) + (size_t)g * 256 * 1024, 1024,
                    256, 1024, 0, half * 128, smem, acc);
      float* E = (float*)(ws + OFF_E);
#pragma unroll
      for (int i = 0; i < 4; i++)
#pragma unroll
        for (int j = 0; j < 4; j++)
#pragma unroll
          for (int jj = 0; jj < 4; jj++) {
            const int st = i * 16 + (lane >> 4) * 4 + jj;
            const int chunk = half * 128 + wc * 64 + j * 16 + (lane & 15);
            E[(((size_t)g * 256 + chunk) * 64 + st) * 2 + wr] = acc[i][j][jj];
          }
    }
  }
  if (((((int)gridDim.x - 33 - (int)blockIdx.x) % (int)gridDim.x + (int)gridDim.x) % (int)gridDim.x) < 64)
    dep_publish((unsigned*)(ws + OFF_WQ_SSM3 + 512));
  {
    const int lane = get_tid() & 63, wid = get_tid() >> 6, wr = wid >> 1, wc = wid & 1;
    for (int task = gridDim.x - 1 - blockIdx.x; task < 32; task += gridDim.x) {
      const int prob = task >> 3, tm = task & 7;
      const int kv = prob >> 1, g = prob & 1;
      const bf16_t* A = (const bf16_t*)(ws + OFF_KV + (size_t)kv * KV_STRIDE) + (size_t)g * SEQ * 64;
      const bf16_t* Bt = (const bf16_t*)(ws + (kv ? OFF_W1V : OFF_W1K));
      const float* bias = (const float*)(ws + (kv ? OFF_BIASV : OFF_BIASK));
      bf16_t* HID = (bf16_t*)(ws + OFF_HID) + (size_t)prob * 1024 * 128;
      f32x4 acc[4][4];
      gemm_tile_128(A, 1024, 1023, Bt, 2048, 128, 2048, tm * 128, 0, smem, acc);
#pragma unroll
      for (int i = 0; i < 4; i++)
#pragma unroll
        for (int j = 0; j < 4; j++)
#pragma unroll
          for (int jj = 0; jj < 4; jj++) {
            int row = tm * 128 + wr * 64 + i * 16 + (lane >> 4) * 4 + jj;
            int col = wc * 64 + j * 16 + (lane & 15);
            if (row < 1023) HID[(size_t)row * 128 + col] = f2bf(gelu_tanh(acc[i][j][jj] + bias[col]));
          }
      asm volatile("s_waitcnt vmcnt(0)" ::: "memory");
      __syncthreads();
      phase3_task(p, smem, task);
    }
  }
  __syncthreads();
  {
    const int nwin = max((int)gridDim.x >> 1, 1);
    if ((int)blockIdx.x < nwin) {
      for (int bt = blockIdx.x; bt < 512; bt += nwin) {
        const int wt = bt * 4 + (get_tid() >> 6);
        attn_tile_task<1>(p, wt >> 1, wt & 1, (float*)smem);
      }
    }
  }
  {
    unsigned* head = (unsigned*)(p.ws + OFF_WQ_SSM3 + 256);
    volatile int* tick = (volatile int*)(smem + SMEM_BYTES - 32);
    for (;;) {
      __syncthreads();
      if (get_tid() == 0) *tick = (int)__hip_atomic_fetch_add(head, 1u, __ATOMIC_RELAXED, __HIP_MEMORY_SCOPE_AGENT);
      __syncthreads();
      const int item0 = *tick;
      if (item0 >= 32 + 512 + 256 + 224) break;
      if (item0 >= 512 + 256 + 224) {
        dep_wait((unsigned*)(ws + OFF_WQ_SSM3 + 512), min(64u, (unsigned)gridDim.x));
        phase3_task(p, smem, 32 + item0 - (512 + 256 + 224));
        continue;
      }
      if (item0 >= 256 + 224) {
        s5_operator_item(p, smem, item0 - (256 + 224));
        continue;
      }
      const int item = item0;
      if (item < 256) {
        convert_item(p, item);
      } else {
        if (item - 256 < 96) {
          for (int k = 0; k < 4; k++) {
            const int t = (item - 256) * 4 + k;
            if (t < 128) transpose_job(p.in[17], 512, 1024, (bf16_t*)(ws + OFF_WGLU), 1024, 2, t, smem);
            else transpose_job(p.in[18], 1024, 1024, (bf16_t*)(ws + OFF_WOUT), 1024, 0, t - 128, smem);
          }
        } else {
          const int w = item - 256 - 96, hh = w >> 3, kt = w & 7;
          f32x4 acc[4][4];
          gemm_tile_128((const bf16_t*)(ws + OFF_SUBT) + (size_t)(hh & 1) * 128 * 128, 128, 128, (const bf16_t*)(ws + OFF_WQB) + hh * 128, 2048,
                        1024, 128, 0, kt * 128, smem, acc);
          const int lane = get_tid() & 63, wid = get_tid() >> 6, wr = wid >> 1, wc = wid & 1;
          bf16_t* WP = (bf16_t*)(ws + OFF_WQ) + (size_t)hh * 128 * 1024 + kt * 128;
#pragma unroll
          for (int i = 0; i < 4; i++)
#pragma unroll
            for (int j = 0; j < 4; j++)
#pragma unroll
              for (int jj = 0; jj < 4; jj++)
                WP[(size_t)(wr * 64 + i * 16 + (lane >> 4) * 4 + jj) * 1024 + wc * 64 + j * 16 + (lane & 15)] = f2bf(acc[i][j][jj]);
        }
      }
    }
  }
}

#define LOG2E_F 1.4426950408889634f
#define NEGC (-1e30f)
#define IMP_STRIDE 258
__device__ __forceinline__ bf16x8 ldfrag(const bf16_t* p) { return *(const bf16x8*)p; }
__device__ __forceinline__ bf16x8 pack8(const float (&v)[8]) {
  u32x4 w = {pack2(v[0], v[1]), pack2(v[2], v[3]), pack2(v[4], v[5]), pack2(v[6], v[7])};
  return __builtin_bit_cast(bf16x8, w);
}
__device__ __forceinline__ float ex2(float x) { return __builtin_amdgcn_exp2f(x); }
__device__ __forceinline__ void qk_tile(const bf16x8 (&kf)[4], const bf16x8& q0, const bf16x8& q1, f32x4& sa, f32x4& sb) {
  const f32x4 z = {0.f, 0.f, 0.f, 0.f};
  sa = __builtin_amdgcn_mfma_f32_16x16x32_bf16(kf[0], q0, z, 0, 0, 0);
  sa = __builtin_amdgcn_mfma_f32_16x16x32_bf16(kf[1], q1, sa, 0, 0, 0);
  sb = __builtin_amdgcn_mfma_f32_16x16x32_bf16(kf[2], q0, z, 0, 0, 0);
  sb = __builtin_amdgcn_mfma_f32_16x16x32_bf16(kf[3], q1, sb, 0, 0, 0);
}
__device__ __forceinline__ void load_k(bf16x8 (&kf)[4], const bf16_t* kr) {
  kf[0] = ldfrag(kr);
  kf[1] = ldfrag(kr + 32);
  kf[2] = ldfrag(kr + 256);
  kf[3] = ldfrag(kr + 288);
}
__device__ __forceinline__ void load_v(bf16x8 (&vf)[4], const bf16_t* vr, size_t ldv16) {
  vf[0] = ldfrag(vr);
  vf[1] = ldfrag(vr + ldv16);
  vf[2] = ldfrag(vr + 2 * ldv16);
  vf[3] = ldfrag(vr + 3 * ldv16);
}

template <int MODE>
__device__ __forceinline__ void attn_tile_task(const Params& p, int tt, int g, float* impw) {
  char* ws = p.ws;
  const int lane = get_tid() & 63, col = lane & 15, q = lane >> 4;
  const int t0 = tt * 16, tok = t0 + col;
  const bf16_t* Qp = (const bf16_t*)(ws + OFF_Q) + ((size_t)tok * 8 + g * 4) * 64 + 8 * q;
  const bf16_t* Kb;
  const bf16_t* Vb;
  size_t ldv;
  int kt_lo, kt_hi;
  if (MODE == 0) {
    Kb = (const bf16_t*)(ws + OFF_KC) + (size_t)g * 1024 * 64;
    Vb = (const bf16_t*)(ws + OFF_VC) + (size_t)g * 64 * 1024;
    ldv = 1024;
    kt_lo = 0;
    kt_hi = (t0 + 15 >= 31) ? (((t0 + 15 - 31) >> 4) >> 5) : -1;
  } else {
    Kb = (const bf16_t*)(ws + OFF_KV + 4 * KV_STRIDE) + (size_t)g * SEQ * 64;
    Vb = (const bf16_t*)(ws + OFF_KV + 5 * KV_STRIDE) + (size_t)g * 64 * SEQ;
    ldv = SEQ;
    kt_lo = max(t0 - 511, 0) >> 5;
    kt_hi = (t0 + 15) >> 5;
  }
  const int hi_lim = (MODE == 0) ? ((tok >= 31) ? ((tok - 31) >> 4) : -1) : tok;
  const int lo_lim = (MODE == 0) ? 0 : tok - 511;
  bf16x8 qf[4][2];
#pragma unroll
  for (int h = 0; h < 4; h++) {
    qf[h][0] = ldfrag(Qp + h * 64);
    qf[h][1] = ldfrag(Qp + h * 64 + 32);
  }
  const int mA = 8 * (col >> 2) + (col & 3);
  const bf16_t* Krow = Kb + (size_t)mA * 64 + 8 * q;
  const bf16_t* Vrow = Vb + (size_t)col * ldv + 8 * q;
  const size_t ldv16 = 16 * ldv;
  float mrun[4], lrun[4];
#pragma unroll
  for (int h = 0; h < 4; h++) { mrun[h] = NEGC; lrun[h] = 0.f; }

  const int hi_min = (MODE == 0) ? ((t0 >= 31) ? ((t0 - 31) >> 4) : -1) : t0;
  const int lo_max = (MODE == 0) ? 0 : t0 + 15 - 511;
  auto body1 = [&](const bf16x8 (&kf)[4], int kt, auto masked) __attribute__((always_inline)) {
    constexpr bool MK = decltype(masked)::value;
    const int key0 = kt * 32 + 8 * q;
#pragma unroll
    for (int h = 0; h < 4; h++) {
      f32x4 sa, sb;
      qk_tile(kf, qf[h][0], qf[h][1], sa, sb);
      float s[8];
      bool v[8];
#pragma unroll
      for (int r = 0; r < 4; r++) {
        if (MK) {
          int ka = key0 + r, kb2 = key0 + 4 + r;
          v[r] = (ka <= hi_lim) && (ka >= lo_lim);
          v[4 + r] = (kb2 <= hi_lim) && (kb2 >= lo_lim);
          s[r] = v[r] ? sa[r] * LOG2E_F : NEGC;
          s[4 + r] = v[4 + r] ? sb[r] * LOG2E_F : NEGC;
        } else {
          v[r] = true;
          v[4 + r] = true;
          s[r] = sa[r] * LOG2E_F;
          s[4 + r] = sb[r] * LOG2E_F;
        }
      }
      float tm = fmaxf(fmaxf(fmaxf(s[0], s[1]), fmaxf(s[2], s[3])), fmaxf(fmaxf(s[4], s[5]), fmaxf(s[6], s[7])));
      float mn = fmaxf(mrun[h], tm);
      if (MODE == 0) {
        float e = 0.f;
#pragma unroll
        for (int r = 0; r < 8; r++) e += (!MK || v[r]) ? ex2(s[r] - mn) : 0.f;
        lrun[h] = lrun[h] * ex2(mrun[h] - mn) + e;
      }
      mrun[h] = mn;
    }
  };
  auto run1 = [&](const bf16x8 (&kf)[4], int kt) __attribute__((always_inline)) {
    if (32 * kt + 31 <= hi_min && 32 * kt >= lo_max) body1(kf, kt, std::false_type{});
    else body1(kf, kt, std::true_type{});
  };
  if (kt_lo <= kt_hi) {
    bf16x8 kA[4], kB[4];
    load_k(kA, Krow + (size_t)kt_lo * 2048);
    for (int kt = kt_lo; kt <= kt_hi; kt += 2) {
      if (kt + 1 <= kt_hi) load_k(kB, Krow + (size_t)(kt + 1) * 2048);
      run1(kA, kt);
      if (kt + 1 <= kt_hi) {
        if (kt + 2 <= kt_hi) load_k(kA, Krow + (size_t)(kt + 2) * 2048);
        run1(kB, kt + 1);
      }
    }
  }
  float inv[4];
#pragma unroll
  for (int h = 0; h < 4; h++) {
    float ma = fmaxf(mrun[h], __shfl_xor(mrun[h], 16, 64));
    ma = fmaxf(ma, __shfl_xor(ma, 32, 64));
    if (MODE == 0) {
      float ls = lrun[h] * ex2(mrun[h] - ma);
      ls += __shfl_xor(ls, 16, 64);
      ls += __shfl_xor(ls, 32, 64);
      inv[h] = (ls > 0.f) ? (1.f / ls) : 0.f;
    } else {
      inv[h] = 1.f;
      lrun[h] = 0.f;
    }
    mrun[h] = (MODE == 0) ? ((inv[h] > 0.f) ? ma - __log2f(inv[h]) : 1e30f) : ma;
  }

  f32x4 o[4][4];
#pragma unroll
  for (int h = 0; h < 4; h++)
#pragma unroll
    for (int mt = 0; mt < 4; mt++) o[h][mt] = (f32x4){0.f, 0.f, 0.f, 0.f};
  float carry = 0.f;
  auto body2 = [&](const bf16x8 (&kf)[4], const bf16x8 (&vf)[4], int kt, auto masked) __attribute__((always_inline)) {
    constexpr bool MK = decltype(masked)::value;
    const int key0 = kt * 32 + 8 * q;
    float a4 = 0.f, b4 = 0.f, p3h = 0.f, p7h = 0.f;
#pragma unroll
    for (int h = 0; h < 4; h++) {
      f32x4 sa, sb;
      qk_tile(kf, qf[h][0], qf[h][1], sa, sb);
      float pr[8];
#pragma unroll
      for (int r = 0; r < 4; r++) {
        if (MK) {
          int ka = key0 + r, kb2 = key0 + 4 + r;
          bool va = (ka <= hi_lim) && (ka >= lo_lim);
          bool vb = (kb2 <= hi_lim) && (kb2 >= lo_lim);
          pr[r] = va ? ex2(sa[r] * LOG2E_F - mrun[h]) : 0.f;
          pr[4 + r] = vb ? ex2(sb[r] * LOG2E_F - mrun[h]) : 0.f;
        } else {
          pr[r] = ex2(sa[r] * LOG2E_F - mrun[h]);
          pr[4 + r] = ex2(sb[r] * LOG2E_F - mrun[h]);
        }
      }
      if (MODE == 1) lrun[h] += ((pr[0] + pr[1]) + (pr[2] + pr[3])) + ((pr[4] + pr[5]) + (pr[6] + pr[7]));
      bf16x8 pk = pack8(pr);
#pragma unroll
      for (int mt = 0; mt < 4; mt++) o[h][mt] = __builtin_amdgcn_mfma_f32_16x16x32_bf16(vf[mt], pk, o[h][mt], 0, 0, 0);
      if (MODE == 0) {
        a4 += (pr[0] + pr[1]) + (pr[2] + pr[3]);
        b4 += (pr[4] + pr[5]) + (pr[6] + pr[7]);
        p3h += pr[3];
        p7h += pr[7];
      }
    }
    if (MODE == 0) {
      float rot = __shfl(p7h, (lane + 48) & 63, 64);
      float val = (q == 0) ? carry : rot;
      carry = rot;
      const int m = 8 * kt + 2 * q;
      *(float2*)&impw[col * IMP_STRIDE + m] = make_float2(val + a4, p3h + b4);
    }
  };
  auto run2 = [&](const bf16x8 (&kf)[4], const bf16x8 (&vf)[4], int kt) __attribute__((always_inline)) {
    if (32 * kt + 31 <= hi_min && 32 * kt >= lo_max) body2(kf, vf, kt, std::false_type{});
    else body2(kf, vf, kt, std::true_type{});
  };
  if (kt_lo <= kt_hi) {
    bf16x8 kA[4], kB[4], vA[4], vB[4];
    load_k(kA, Krow + (size_t)kt_lo * 2048);
    load_v(vA, Vrow + (size_t)kt_lo * 32, ldv16);
    for (int kt = kt_lo; kt <= kt_hi; kt += 2) {
      if (kt + 1 <= kt_hi) {
        load_k(kB, Krow + (size_t)(kt + 1) * 2048);
        load_v(vB, Vrow + (size_t)(kt + 1) * 32, ldv16);
      }
      run2(kA, vA, kt);
      if (kt + 1 <= kt_hi) {
        if (kt + 2 <= kt_hi) {
          load_k(kA, Krow + (size_t)(kt + 2) * 2048);
          load_v(vA, Vrow + (size_t)(kt + 2) * 32, ldv16);
        }
        run2(kB, vB, kt + 1);
      }
    }
  }
  if (MODE == 1) {
#pragma unroll
    for (int h = 0; h < 4; h++) {
      float ls = lrun[h];
      ls += __shfl_xor(ls, 16, 64);
      ls += __shfl_xor(ls, 32, 64);
      const float iv = (ls > 0.f) ? (1.f / ls) : 0.f;
#pragma unroll
      for (int mt = 0; mt < 4; mt++) o[h][mt] = o[h][mt] * iv;
    }
  }
  {
    bf16_t* dst = (bf16_t*)(ws + OFF_Z + (MODE == 0 ? 0ull : 16 * MB)) + (size_t)tok * 512 + g * 256 + 4 * q;
#pragma unroll
    for (int h = 0; h < 4; h++)
#pragma unroll
      for (int mt = 0; mt < 4; mt++) {
        uint2 w;
        w.x = pack2(o[h][mt][0], o[h][mt][1]);
        w.y = pack2(o[h][mt][2], o[h][mt][3]);
        *(uint2*)(dst + h * 64 + mt * 16) = w;
      }
  }
  if (MODE == 0) {
    wave_lds_sync();
    unsigned char* SEL = (unsigned char*)(ws + OFF_HID);
#pragma unroll 1
    for (int rd = 0; rd < 4; rd++) {
      const int tsel = 4 * rd + q;
      const int tk = t0 + tsel;
      const int cur = tk >> 6;
      unsigned kk[16];
#pragma unroll
      for (int c = 0; c < 16; c++) {
        const int m = col + 16 * c;
        unsigned bits = __float_as_uint(impw[tsel * IMP_STRIDE + m]);
        kk[c] = (m >= 1 && m <= cur - 2) ? ((bits & 0xFFFFFF00u) | (unsigned)(255 - m)) : 0u;
      }
      unsigned myidx = 0;
#pragma unroll 1
      for (int r = 0; r < 13; r++) {
        unsigned w = kk[0];
#pragma unroll
        for (int c = 1; c < 16; c++) w = max(w, kk[c]);
        w = max(w, (unsigned)__builtin_amdgcn_update_dpp(0u, w, 0x128, 0xF, 0xF, false));
        w = max(w, (unsigned)__builtin_amdgcn_update_dpp(0u, w, 0x124, 0xF, 0xF, false));
        w = max(w, (unsigned)__builtin_amdgcn_update_dpp(0u, w, 0x122, 0xF, 0xF, false));
        w = max(w, (unsigned)__builtin_amdgcn_update_dpp(0u, w, 0x121, 0xF, 0xF, false));
        if (col == r) myidx = 255u - (w & 255u);
#pragma unroll
        for (int c = 0; c < 16; c++) kk[c] = (kk[c] == w) ? 0u : kk[c];
      }
      if (cur >= 16) {
        unsigned char* sp = SEL + ((size_t)tk * 2 + g) * 16;
        if (col < 13) sp[3 + col] = (unsigned char)myidx;
        if (col == 13) sp[0] = 0;
        if (col == 14) sp[1] = (unsigned char)(cur - 1);
        if (col == 15) sp[2] = (unsigned char)cur;
      }
    }
    wave_lds_sync();
  }
}

__device__ __forceinline__ long mk64(unsigned lo, unsigned hi) { return (long)(((unsigned long long)hi << 32) | (unsigned long long)lo); }
__device__ __forceinline__ f32x4 mfma8(long a, long b, f32x4 c) { return __builtin_amdgcn_mfma_f32_16x16x32_fp8_fp8(a, b, c, 0, 0, 0); }
__device__ __forceinline__ void attn_sel_task(const Params& p, int t0, int g, char* wlds) {
  char* ws = p.ws;
  const int lane = get_tid() & 63, col = lane & 15, q = lane >> 4;
  const int tok = col >> 2, hd = col & 3, t = t0 + tok;
  long q0, q1;
  {
    const bf16_t* Qp = (const bf16_t*)(ws + OFF_Q) + ((size_t)t * 8 + g * 4 + hd) * 64 + 16 * q;
    uint4 qa = *(const uint4*)Qp, qb = *(const uint4*)(Qp + 8);
    const float sc = 64.f;
    int w0 = __builtin_amdgcn_cvt_pk_fp8_f32(bflo(qa.x) * sc, bfhi(qa.x) * sc, 0, false);
    w0 = __builtin_amdgcn_cvt_pk_fp8_f32(bflo(qa.y) * sc, bfhi(qa.y) * sc, w0, true);
    int w1 = __builtin_amdgcn_cvt_pk_fp8_f32(bflo(qa.z) * sc, bfhi(qa.z) * sc, 0, false);
    w1 = __builtin_amdgcn_cvt_pk_fp8_f32(bflo(qa.w) * sc, bfhi(qa.w) * sc, w1, true);
    int w2 = __builtin_amdgcn_cvt_pk_fp8_f32(bflo(qb.x) * sc, bfhi(qb.x) * sc, 0, false);
    w2 = __builtin_amdgcn_cvt_pk_fp8_f32(bflo(qb.y) * sc, bfhi(qb.y) * sc, w2, true);
    int w3 = __builtin_amdgcn_cvt_pk_fp8_f32(bflo(qb.z) * sc, bfhi(qb.z) * sc, 0, false);
    w3 = __builtin_amdgcn_cvt_pk_fp8_f32(bflo(qb.w) * sc, bfhi(qb.w) * sc, w3, true);
    q0 = mk64((unsigned)w0, (unsigned)w1);
    q1 = mk64((unsigned)w2, (unsigned)w3);
  }
  const unsigned char* Krow = (const unsigned char*)(ws + OFF_KV + 2 * KV_STRIDE) + (size_t)g * SEQ * 64 +
                              (size_t)(16 * (col >> 2) + (col & 3)) * 64 + 16 * q;
  const unsigned char* Vrow = (const unsigned char*)(ws + OFF_KV + 3 * KV_STRIDE) + (size_t)g * 256 * 4096 + (size_t)col * 64 + 16 * q;
  const int cur = t0 >> 6;
  LAS unsigned* flags = (LAS unsigned*)wlds;
  LAS unsigned* list = (LAS unsigned*)(wlds + 256);
  wave_lds_sync();
  flags[lane] = 0u;
  wave_lds_sync();
  {
    const int tk = lane >> 4, e = lane & 15;
    int id = -1;
    if (cur >= 16) id = (int)((const unsigned char*)(ws + OFF_HID))[((size_t)(t0 + tk) * 2 + g) * 16 + e];
    else if (e <= cur) id = e;
    if (id >= 0) (void)__hip_atomic_fetch_or(&flags[id >> 2], (1u << tk) << (8 * (id & 3)), __ATOMIC_RELAXED, __HIP_MEMORY_SCOPE_WORKGROUP);
  }
  wave_lds_sync();
  int n = 0;
  {
    const unsigned fw = flags[lane];
    const unsigned long long lt = (1ull << lane) - 1ull;
#pragma unroll
    for (int qq = 0; qq < 4; qq++) {
      const unsigned m = (fw >> (8 * qq)) & 15u;
      const unsigned long long bal = __ballot(m != 0u);
      if (m != 0u) list[n + __popcll(bal & lt)] = (unsigned)(4 * lane + qq) | (m << 8);
      n += __popcll(bal);
    }
  }
  wave_lds_sync();
  auto load_blk = [&](u32x4 (&kf)[4], u32x4 (&vf)[4], int blk) __attribute__((always_inline)) {
    const unsigned char* kr = Krow + (size_t)blk * 4096;
    kf[0] = *(const u32x4*)(kr);
    kf[1] = *(const u32x4*)(kr + 256);
    kf[2] = *(const u32x4*)(kr + 512);
    kf[3] = *(const u32x4*)(kr + 768);
    const unsigned char* vr = Vrow + (size_t)blk * 4096;
    vf[0] = *(const u32x4*)(vr);
    vf[1] = *(const u32x4*)(vr + 1024);
    vf[2] = *(const u32x4*)(vr + 2048);
    vf[3] = *(const u32x4*)(vr + 3072);
  };
  float mrun = -1.0e4f, lrun = 0.f;
  f32x4 o[4];
#pragma unroll
  for (int mt = 0; mt < 4; mt++) o[mt] = (f32x4){0.f, 0.f, 0.f, 0.f};
  const float SSC = LOG2E_F * (1.f / 512.f);
  auto body = [&](const u32x4 (&kf)[4], const u32x4 (&vf)[4], unsigned ent) __attribute__((always_inline)) {
    const int blk = (int)(ent & 255u);
    const unsigned msk = ent >> 8;
    const bool valid = ((msk >> tok) & 1u) != 0u;
    const f32x4 z = {0.f, 0.f, 0.f, 0.f};
    f32x4 sa0 = mfma8(mk64(kf[0].x, kf[0].y), q0, z);
    sa0 = mfma8(mk64(kf[0].z, kf[0].w), q1, sa0);
    f32x4 sb0 = mfma8(mk64(kf[1].x, kf[1].y), q0, z);
    sb0 = mfma8(mk64(kf[1].z, kf[1].w), q1, sb0);
    f32x4 sa1 = mfma8(mk64(kf[2].x, kf[2].y), q0, z);
    sa1 = mfma8(mk64(kf[2].z, kf[2].w), q1, sa1);
    f32x4 sb1 = mfma8(mk64(kf[3].x, kf[3].y), q0, z);
    sb1 = mfma8(mk64(kf[3].z, kf[3].w), q1, sb1);
    float s[16];
#pragma unroll
    for (int r = 0; r < 4; r++) {
      s[r] = sa0[r];
      s[4 + r] = sb0[r];
      s[8 + r] = sa1[r];
      s[12 + r] = sb1[r];
    }
    if (blk == cur) {
      const int key0 = blk * 64 + 16 * q;
      const int lim = valid ? t : -1;
#pragma unroll
      for (int r = 0; r < 8; r++) {
        s[r] = (key0 + r <= lim) ? s[r] : -1e30f;
        s[8 + r] = (key0 + 8 + r <= lim) ? s[8 + r] : -1e30f;
      }
    }
    float tm = fmaxf(fmaxf(fmaxf(s[0], s[1]), fmaxf(s[2], s[3])), fmaxf(fmaxf(s[4], s[5]), fmaxf(s[6], s[7])));
    float tm2 = fmaxf(fmaxf(fmaxf(s[8], s[9]), fmaxf(s[10], s[11])), fmaxf(fmaxf(s[12], s[13]), fmaxf(s[14], s[15])));
    tm = fmaxf(tm, tm2);
    tm = valid ? tm : -1e30f;
    tm *= SSC;
    if (!__all(tm <= mrun + 1.0f)) {
      tm = fmaxf(tm, __shfl_xor(tm, 16, 64));
      tm = fmaxf(tm, __shfl_xor(tm, 32, 64));
      const float mn = fmaxf(mrun, tm);
      const float alpha = ex2(mrun - mn);
      mrun = mn;
      lrun *= alpha;
#pragma unroll
      for (int mt = 0; mt < 4; mt++) {
        o[mt][0] *= alpha; o[mt][1] *= alpha; o[mt][2] *= alpha; o[mt][3] *= alpha;
      }
    }
    float pr[16];
    const float mb = valid ? 7.f - mrun : -1e30f;
#pragma unroll
    for (int r = 0; r < 16; r++) pr[r] = ex2(__builtin_fmaf(s[r], SSC, mb));
    lrun += ((pr[0] + pr[1]) + (pr[2] + pr[3])) + ((pr[4] + pr[5]) + (pr[6] + pr[7])) +
            ((pr[8] + pr[9]) + (pr[10] + pr[11])) + ((pr[12] + pr[13]) + (pr[14] + pr[15]));
    int w0 = __builtin_amdgcn_cvt_pk_fp8_f32(pr[0], pr[1], 0, false);
    w0 = __builtin_amdgcn_cvt_pk_fp8_f32(pr[2], pr[3], w0, true);
    int w1 = __builtin_amdgcn_cvt_pk_fp8_f32(pr[4], pr[5], 0, false);
    w1 = __builtin_amdgcn_cvt_pk_fp8_f32(pr[6], pr[7], w1, true);
    int w2 = __builtin_amdgcn_cvt_pk_fp8_f32(pr[8], pr[9], 0, false);
    w2 = __builtin_amdgcn_cvt_pk_fp8_f32(pr[10], pr[11], w2, true);
    int w3 = __builtin_amdgcn_cvt_pk_fp8_f32(pr[12], pr[13], 0, false);
    w3 = __builtin_amdgcn_cvt_pk_fp8_f32(pr[14], pr[15], w3, true);
    const long pk0 = mk64((unsigned)w0, (unsigned)w1), pk1 = mk64((unsigned)w2, (unsigned)w3);
#pragma unroll
    for (int mt = 0; mt < 4; mt++) {
      o[mt] = mfma8(mk64(vf[mt].x, vf[mt].y), pk0, o[mt]);
      o[mt] = mfma8(mk64(vf[mt].z, vf[mt].w), pk1, o[mt]);
    }
  };
  {
    u32x4 kA[4], vA[4], kB[4], vB[4];
    unsigned entA = (unsigned)__builtin_amdgcn_readfirstlane((int)list[0]), entB = 0u;
    load_blk(kA, vA, (int)(entA & 255u));
#pragma unroll 1
    for (int b = 0; b < n; b += 2) {
      if (b + 1 < n) {
        entB = (unsigned)__builtin_amdgcn_readfirstlane((int)list[b + 1]);
        load_blk(kB, vB, (int)(entB & 255u));
      }
      body(kA, vA, entA);
      if (b + 1 < n) {
        if (b + 2 < n) {
          entA = (unsigned)__builtin_amdgcn_readfirstlane((int)list[b + 2]);
          load_blk(kA, vA, (int)(entA & 255u));
        }
        body(kB, vB, entB);
      }
    }
  }
  {
    float ls = lrun;
    ls += __shfl_xor(ls, 16, 64);
    ls += __shfl_xor(ls, 32, 64);
    const float inv = (ls > 0.f) ? (0.125f / ls) : 0.f;
#pragma unroll
    for (int mt = 0; mt < 4; mt++) {
      o[mt][0] *= inv; o[mt][1] *= inv; o[mt][2] *= inv; o[mt][3] *= inv;
    }
  }
  {
    const float* gt = (const float*)(ws + OFF_GATES) + (size_t)t * 24 + (g * 4 + hd) * 3;
    const float gc = gt[0], gs = gt[1], gw = gt[2];
    const size_t off = (size_t)t * 512 + (g * 4 + hd) * 64 + 4 * q;
    const bf16_t* OC = (const bf16_t*)(ws + OFF_Z) + off;
    const bf16_t* OW = (const bf16_t*)(ws + OFF_Z + 16 * MB) + off;
    bf16_t* MIX = (bf16_t*)(ws + OFF_MIX) + (size_t)t * 1024 + (g * 4 + hd) * 64 + 4 * q;
#pragma unroll
    for (int mt = 0; mt < 4; mt++) {
      uint2 c2 = *(const uint2*)(OC + mt * 16);
      uint2 w2 = *(const uint2*)(OW + mt * 16);
      float r0 = gc * bflo(c2.x) + gs * o[mt][0] + gw * bflo(w2.x);
      float r1 = gc * bfhi(c2.x) + gs * o[mt][1] + gw * bfhi(w2.x);
      float r2 = gc * bflo(c2.y) + gs * o[mt][2] + gw * bflo(w2.y);
      float r3 = gc * bfhi(c2.y) + gs * o[mt][3] + gw * bfhi(w2.y);
      uint2 wv;
      wv.x = pack2(r0, r1);
      wv.y = pack2(r2, r3);
      *(uint2*)(MIX + mt * 16) = wv;
    }
  }
}
__device__ __forceinline__ void phase4(const Params& p, char* smem) {
  const int wid = get_tid() >> 6;
  float* impw = (float*)(smem + wid * (16 * IMP_STRIDE * 4));
  {
    const int half = max((int)gridDim.x >> 1, 1);
    if ((int)blockIdx.x < half) {
      for (int pw = blockIdx.x * 4 + wid; pw < 1024; pw += half * 4) {
        const int g = pw & 1, k = pw >> 1;
        attn_tile_task<0>(p, 1023 - k, g, impw);
        attn_tile_task<0>(p, k, g, impw);
      }
    }
  }
  unsigned* head = (unsigned*)(p.ws + OFF_WQ_SSM3);
  volatile int* tick = (volatile int*)(smem + SMEM_BYTES - 32);
  for (;;) {
    __syncthreads();
    if (get_tid() == 0) *tick = (int)__hip_atomic_fetch_add(head, 1u, __ATOMIC_RELAXED, __HIP_MEMORY_SCOPE_AGENT);
    __syncthreads();
    const int task = *tick;
    if (task >= 512) break;
    s5_output_tile(p, smem, task);
  }
}
__device__ __forceinline__ unsigned hw_xcc_id() { return (unsigned)__builtin_amdgcn_s_getreg((3 << 11) | 20) & 0x7u; }
#define OFF_WQ_CNT (244 * MB + 16384)
__device__ __forceinline__ void phase4b(const Params& p, char* smem) {
  const int wid = get_tid() >> 6;
  unsigned* qcnt = (unsigned*)(p.ws + OFF_WQ_CNT);
  volatile int* tick = (volatile int*)(smem + SMEM_BYTES - 32);
  const unsigned x = hw_xcc_id();
  for (int k = 0; k < 8; k++) {
    const int part = (int)((x + k) & 7u);
    const int g = part & 1, quarter = part >> 1;
    for (;;) {
      __syncthreads();
      if (get_tid() == 0) *tick = (int)__hip_atomic_fetch_add(&qcnt[part * 64], 1u, __ATOMIC_RELAXED, __HIP_MEMORY_SCOPE_AGENT);
      __syncthreads();
      const int bt = *tick;
      if (bt >= 256) break;
      const int t0 = quarter * 4096 + 16 * (255 - bt) + 4 * wid;
      attn_sel_task(p, t0, g, smem + wid * 512);
    }
  }
}

__device__ __forceinline__ void phase5(const Params& p, char* smem) {
  char* ws = p.ws;
  const int lane = get_tid() & 63, wid = get_tid() >> 6, wr = wid >> 1, wc = wid & 1;
  const bf16_t* YG = (const bf16_t*)(ws + OFF_YG);
  const bf16_t* W = (const bf16_t*)(ws + OFF_WGLU);
  bf16_t* MIX = (bf16_t*)(ws + OFF_MIX);
  for (int tile = blockIdx.x; tile < 128 * 8; tile += gridDim.x) {
    const int tm = tile >> 3, tn = tile & 7;
    f32x4 acc[4][4];
    gemm_tile_128(YG, 512, SEQ, W, 512, 1024, 512, tm * 128, tn * 128, smem, acc);
    const int b64 = tn * 2 + wc;
    {
      const float* t = stage_acc(acc, smem);
      const int rs = lane >> 2, c8 = (lane & 3) * 8;
#pragma unroll
      for (int it = 0; it < 4; it++) {
        const int r = it * 16 + rs;
        const float* tr = t + r * EPI_LD;
        float4 a0 = *(const float4*)(tr + c8), a1 = *(const float4*)(tr + c8 + 4);
        float4 b0 = *(const float4*)(tr + 32 + c8), b1 = *(const float4*)(tr + 32 + c8 + 4);
        uint4 w;
        w.x = pack2(a0.x * sigmoid_f(b0.x), a0.y * sigmoid_f(b0.y));
        w.y = pack2(a0.z * sigmoid_f(b0.z), a0.w * sigmoid_f(b0.w));
        w.z = pack2(a1.x * sigmoid_f(b1.x), a1.y * sigmoid_f(b1.y));
        w.w = pack2(a1.z * sigmoid_f(b1.z), a1.w * sigmoid_f(b1.w));
        *(uint4*)(MIX + (size_t)(tm * 128 + wr * 64 + r) * 1024 + 512 + 32 * b64 + c8) = w;
      }
      __syncthreads();
    }
  }
}

__device__ __forceinline__ void phase6(const Params& p, char* smem) {
  char* ws = p.ws;
  const int lane = get_tid() & 63, wid = get_tid() >> 6, wr = wid >> 1, wc = wid & 1;
  const bf16_t* MIX = (const bf16_t*)(ws + OFF_MIX);
  const bf16_t* W = (const bf16_t*)(ws + OFF_WOUT);
  const float* x = p.in[0];
  float* h1 = p.out;
  for (int tile = blockIdx.x; tile < 128 * 8; tile += gridDim.x) {
    const int tm = tile >> 3, tn = tile & 7;
    f32x4 acc[4][4];
    gemm_tile_128(MIX, 1024, SEQ, W, 1024, 1024, 1024, tm * 128, tn * 128, smem, acc);
    {
      const float* t = stage_acc(acc, smem);
      const int rs = lane >> 4, c4 = (lane & 15) * 4;
      const float4 gg = *(const float4*)(p.in[19] + tn * 128 + wc * 64 + c4);
      bf16_t* XW = (bf16_t*)(ws + OFF_Z);
      float* SSQ = (float*)(ws + OFF_SSQ);
#pragma unroll 4
      for (int it = 0; it < 16; it++) {
        const int r = it * 4 + rs;
        const size_t row = (size_t)(tm * 128 + wr * 64 + r);
        const size_t o = row * 1024 + tn * 128 + wc * 64 + c4;
        float4 a = *(const float4*)(t + r * EPI_LD + c4);
        float4 xv = *(const float4*)(x + o);
        const float4 hv = make_float4(xv.x + a.x, xv.y + a.y, xv.z + a.z, xv.w + a.w);
        *(float4*)(h1 + o) = hv;
        uint2 w;
        w.x = pack2(hv.x * gg.x, hv.y * gg.y);
        w.y = pack2(hv.z * gg.z, hv.w * gg.w);
        *(uint2*)(XW + o) = w;
        float ss = (hv.x * hv.x + hv.y * hv.y) + (hv.z * hv.z + hv.w * hv.w);
        ss += __uint_as_float((unsigned)__builtin_amdgcn_update_dpp(0u, __float_as_uint(ss), 0x128, 0xF, 0xF, false));
        ss += __uint_as_float((unsigned)__builtin_amdgcn_update_dpp(0u, __float_as_uint(ss), 0x124, 0xF, 0xF, false));
        ss += __uint_as_float((unsigned)__builtin_amdgcn_update_dpp(0u, __float_as_uint(ss), 0x122, 0xF, 0xF, false));
        ss += __uint_as_float((unsigned)__builtin_amdgcn_update_dpp(0u, __float_as_uint(ss), 0x121, 0xF, 0xF, false));
        if ((lane & 15) == 0) SSQ[row * 16 + tn * 2 + wc] = ss;
      }
      __syncthreads();
    }
  }
}

#define OFF_TOPV (112 * MB)
#define OFF_TOPI (OFF_TOPV + 16 * MB)
__device__ __forceinline__ void phase8(const Params& p, char* smem) {
  char* ws = p.ws;
  bf16_t(*sQ)[136] = (bf16_t(*)[136])smem;
  float(*sS)[132] = (float(*)[132])smem;
  for (int tile = blockIdx.x; tile < 128 * 16; tile += gridDim.x) {
    const int tm = tile >> 4, tn = tile & 15;
    const int h = tn >> 1, hf = tn & 1;
    float* rsq = (float*)(smem + 73728);
    if (get_tid() < 128) {
      const float4* pp = (const float4*)((const float*)(ws + OFF_SSQ) + (size_t)(tm * 128 + get_tid()) * 16);
      const float4 a = pp[0], b = pp[1], c = pp[2], d = pp[3];
      const float ss = (((a.x + a.y) + (a.z + a.w)) + ((b.x + b.y) + (b.z + b.w))) + (((c.x + c.y) + (c.z + c.w)) + ((d.x + d.y) + (d.z + d.w)));
      rsq[get_tid()] = rsqrtf(ss * (1.f / 1024.f) + 1e-6f);
    }
    f32x4 acc[4][4];
    gemm_tile_128((const bf16_t*)(ws + OFF_Z), 1024, SEQ, (const bf16_t*)(ws + OFF_WQ), 1024, 2048, 1024, tm * 128, tn * 128, smem, acc);
    const int lane = get_tid() & 63, wid = get_tid() >> 6, wr = wid >> 1, wc = wid & 1;
    const int col = lane & 15, q = lane >> 4;
    float* TOPV = (float*)(ws + OFF_TOPV);
    unsigned char* TOPI = (unsigned char*)(ws + OFF_TOPI);
#pragma unroll
    for (int i = 0; i < 4; i++) {
      const float4 rv = *(const float4*)&rsq[wr * 64 + i * 16 + q * 4];
      const float rr[4] = {rv.x, rv.y, rv.z, rv.w};
#pragma unroll
      for (int j = 0; j < 4; j++)
#pragma unroll
        for (int jj = 0; jj < 4; jj++) sS[wr * 64 + i * 16 + q * 4 + jj][wc * 64 + j * 16 + col] = acc[i][j][jj] * rr[jj];
    }
    __syncthreads();
#pragma unroll 1
    for (int ps = 0; ps < 8; ps++) {
      const int row = wid * 32 + ps * 4 + q;
      unsigned kk[8];
#pragma unroll
      for (int c = 0; c < 8; c++) {
        const int k = col + 16 * c;
        unsigned bits = __float_as_uint(sS[row][k]);
        unsigned u = bits ^ ((unsigned)((int)bits >> 31) | 0x80000000u);
        kk[c] = (u & 0xFFFFFF80u) | (unsigned)(127 - k);
      }
#define CSWAP(a, b) { unsigned hi_ = max(kk[a], kk[b]), lo_ = min(kk[a], kk[b]); kk[a] = hi_; kk[b] = lo_; }
      CSWAP(0, 1) CSWAP(2, 3) CSWAP(4, 5) CSWAP(6, 7)
      CSWAP(0, 2) CSWAP(1, 3) CSWAP(4, 6) CSWAP(5, 7)
      CSWAP(1, 2) CSWAP(5, 6)
      CSWAP(0, 4) CSWAP(1, 5) CSWAP(2, 6) CSWAP(3, 7)
      CSWAP(2, 4) CSWAP(3, 5)
      CSWAP(1, 2) CSWAP(3, 4) CSWAP(5, 6)
#undef CSWAP
      unsigned mine = 0;
#pragma unroll 1
      for (int r = 0; r < 16; r++) {
        unsigned w = kk[0];
        w = max(w, (unsigned)__builtin_amdgcn_update_dpp(0u, w, 0x128, 0xF, 0xF, false));
        w = max(w, (unsigned)__builtin_amdgcn_update_dpp(0u, w, 0x124, 0xF, 0xF, false));
        w = max(w, (unsigned)__builtin_amdgcn_update_dpp(0u, w, 0x122, 0xF, 0xF, false));
        w = max(w, (unsigned)__builtin_amdgcn_update_dpp(0u, w, 0x121, 0xF, 0xF, false));
        if (col == r) mine = w;
        const bool pop = (kk[0] == w);
        kk[0] = pop ? kk[1] : kk[0];
        kk[1] = pop ? kk[2] : kk[1];
        kk[2] = pop ? kk[3] : kk[2];
        kk[3] = pop ? kk[4] : kk[3];
        kk[4] = pop ? kk[5] : kk[4];
        kk[5] = pop ? kk[6] : kk[5];
        kk[6] = pop ? kk[7] : kk[6];
        kk[7] = pop ? 0u : kk[7];
      }
      const int idx = 127 - (int)(mine & 127u);
      const float val = sS[row][idx];
      const size_t o = (((size_t)(tm * 128 + row) * 8 + h) * 2 + hf) * 16 + col;
      TOPV[o] = val;
      TOPI[o] = (unsigned char)idx;
    }
    __syncthreads();
  }
}

__device__ const unsigned char STAIR_TAB[64] = {0, 1, 2, 3, 4, 5, 6, 7, 8, 9, 10, 11, 12, 13, 14, 15, 16, 17, 18, 19, 20, 21, 22, 23, 32, 33, 34, 35, 36, 48, 49, 50, 51, 64, 65, 66, 80, 81, 96, 97, 112, 113, 128, 144, 160, 176, 192, 208, 224, 240, 0, 0, 0, 0, 0, 0, 0, 0, 0, 0, 0, 0, 0, 0};
__device__ __forceinline__ void wave_sort_desc(float& v, int& c, int lane) {
#pragma unroll
  for (int k = 2; k <= 64; k <<= 1) {
#pragma unroll
    for (int j = k >> 1; j > 0; j >>= 1) {
      float ov = __shfl_xor(v, j, 64);
      int oc = __shfl_xor(c, j, 64);
      bool other_first = (ov > v) || (ov == v && oc < c);
      bool lower = (lane & j) == 0;
      bool asc = (lane & k) == 0;
      bool take_first = (lower == asc);
      bool take_other = (take_first == other_first);
      v = take_other ? ov : v;
      c = take_other ? oc : c;
    }
  }
}

__device__ __forceinline__ void phase9(const Params& p, char* smem) {
  char* ws = p.ws;
  const int tid = get_tid(), lane = tid & 63, wid = tid >> 6;
  int* pe = (int*)(smem + wid * 2560);
  float* pg = (float*)(smem + wid * 2560 + 512);
  float* tvl = (float*)(smem + wid * 2560 + 1024);
  unsigned char* til = (unsigned char*)(smem + wid * 2560 + 2048);
  const float* TOPV = (const float*)(ws + OFF_TOPV);
  const unsigned char* TOPI = (const unsigned char*)(ws + OFF_TOPI);
  const bf16_t* XN = (const bf16_t*)(ws + OFF_Z);
  const unsigned char* UT8 = (const unsigned char*)(ws + OFF_UT);
  const unsigned char* VT8 = UT8 + 16 * MB;
  const float* fng = p.in[25];
  const int st = STAIR_TAB[lane];
  const int sti = st >> 4, stj = st & 15;
  for (int t = blockIdx.x * 4 + wid; t < SEQ; t += gridDim.x * 4) {
    wave_lds_sync();
    {
      const char* wsl = ws;
      asm volatile("" : "+s"(wsl));
      const int l4 = 4 * (get_tid() & 63);
      *(float4*)(tvl + l4) = *(const float4*)((const float*)(wsl + OFF_TOPV) + (size_t)t * 256 + l4);
      *(unsigned*)(til + l4) = *(const unsigned*)((const unsigned char*)(wsl + OFF_TOPI) + (size_t)t * 256 + l4);
    }
    wave_lds_sync();
#pragma unroll 1
    for (int h = 0; h < 8; h++) {
      const float cvx = tvl[h * 32 + sti] + tvl[h * 32 + 16 + stj];
      const unsigned bits = __float_as_uint(cvx);
      unsigned key = ((bits ^ ((unsigned)((int)bits >> 31) | 0x80000000u)) & 0xFFFFFF00u) | (unsigned)(255 - st);
      if (lane >= 50) key = 0u;
#pragma unroll
      for (int k = 2; k <= 64; k <<= 1) {
#pragma unroll
        for (int j = k >> 1; j > 0; j >>= 1) {
          const unsigned other = (unsigned)__shfl_xor((int)key, j, 64);
          const bool take_max = (((lane & j) == 0) == ((lane & k) == 0));
          key = take_max ? max(key, other) : min(key, other);
        }
      }
      const int cc = 255 - (int)(key & 255u);
      const float cv = tvl[h * 32 + ((cc >> 4) & 15)] + tvl[h * 32 + 16 + (cc & 15)];
      float mx = __shfl(cv, 0, 64);
      float ex = (lane < 16) ? expf(cv - mx) : 0.f;
      float sm = wave_sum(ex);
      if (lane < 16) {
        const int e = (int)til[h * 32 + ((cc >> 4) & 15)] * 128 + (int)til[h * 32 + 16 + (cc & 15)];
        pe[h * 16 + lane] = e;
        pg[h * 16 + lane] = ex / sm;
      }
    }
    wave_lds_sync();
    {
      const int half = lane >> 5, ck = lane & 31;
      float xs[32];
      {
        const bf16_t* xp = XN + (size_t)t * 1024 + 32 * ck;
        float xn[32];
#pragma unroll
        for (int i = 0; i < 4; i++) {
          uint4 a = *(const uint4*)(xp + 8 * i);
          xn[8 * i + 0] = bflo(a.x); xn[8 * i + 1] = bfhi(a.x); xn[8 * i + 2] = bflo(a.y); xn[8 * i + 3] = bfhi(a.y);
          xn[8 * i + 4] = bflo(a.z); xn[8 * i + 5] = bfhi(a.z); xn[8 * i + 6] = bflo(a.w); xn[8 * i + 7] = bfhi(a.w);
        }
        float ssp = 0.f;
        if ((get_tid() & 63) < 16) ssp = ((const float*)(ws + OFF_SSQ))[(size_t)t * 16 + (get_tid() & 63)];
        const float rstd = rsqrtf(wave_sum(ssp) * (1.f / 1024.f) + 1e-6f);
#pragma unroll
        for (int j = 0; j < 32; j++) xs[j] = xn[FP6_COL(j)] * rstd;
      }
      const unsigned char* UT6 = (const unsigned char*)(ws + OFF_UT) + 16 * ck;
      const unsigned char* VT4 = (const unsigned char*)(ws + OFF_UT) + 768 + 16 * ck;
      typedef float f32x2 __attribute__((ext_vector_type(2)));
      f32x2 oacc2[16];
#pragma unroll
      for (int j = 0; j < 16; j++) oacc2[j] = (f32x2){0.f, 0.f};
#define NSL 2
      auto rows_load = [&](uint2 (&ur)[NSL][3], uint4 (&vr)[NSL], float (&gate)[NSL], int pp) __attribute__((always_inline)) {
#pragma unroll
        for (int k = 0; k < NSL; k++) {
          const int pi = min(pp + 2 * k + half, 127);
          const int e = pe[pi];
          gate[k] = (pp + 2 * k + half < 128) ? pg[pi] : 0.f;
          const unsigned char* up = UT6 + (size_t)e * 1280;
          const uint4 ua = *(const uint4*)up;
          ur[k][0] = make_uint2(ua.x, ua.y); ur[k][1] = make_uint2(ua.z, ua.w); ur[k][2] = *(const uint2*)(up + 512 - 8 * ck);
          vr[k] = *(const uint4*)(VT4 + (size_t)e * 1280);
        }
      };
      auto rows_use = [&](const uint2 (&ur)[NSL][3], const uint4 (&vr)[NSL], const float (&gate)[NSL]) __attribute__((always_inline)) {
        float hid[NSL];
#pragma unroll
        for (int k = 0; k < NSL; k++) {
          v6u_t w = {ur[k][0].x, ur[k][0].y, ur[k][1].x, ur[k][1].y, ur[k][2].x, ur[k][2].y};
          v32f_t du = __builtin_amdgcn_cvt_scalef32_pk32_f32_fp6(w, 1.0f);
          float s0 = 0.f, s1 = 0.f;
#pragma unroll
          for (int j = 0; j < 32; j += 2) { s0 += xs[j] * du[j]; s1 += xs[j + 1] * du[j + 1]; }
          hid[k] = s0 + s1;
        }
#pragma unroll
        for (int o = 16; o > 0; o >>= 1) {
#pragma unroll
          for (int k = 0; k < NSL; k++) hid[k] += __shfl_xor(hid[k], o, 64);
        }
#pragma unroll
        for (int k = 0; k < NSL; k++) {
          const float act = gelu_tanh(hid[k] * (1.f / 64.f)) * gate[k];
          typedef float f32x2 __attribute__((ext_vector_type(2)));
          const unsigned wv[4] = {vr[k].x, vr[k].y, vr[k].z, vr[k].w};
          const f32x2 a2 = {act, act};
#pragma unroll
          for (int d = 0; d < 4; d++) {
            oacc2[4 * d + 0] = __builtin_elementwise_fma(a2, __builtin_amdgcn_cvt_scalef32_pk_f32_fp4(wv[d], 1.0f, 0), oacc2[4 * d + 0]);
            oacc2[4 * d + 1] = __builtin_elementwise_fma(a2, __builtin_amdgcn_cvt_scalef32_pk_f32_fp4(wv[d], 1.0f, 1), oacc2[4 * d + 1]);
            oacc2[4 * d + 2] = __builtin_elementwise_fma(a2, __builtin_amdgcn_cvt_scalef32_pk_f32_fp4(wv[d], 1.0f, 2), oacc2[4 * d + 2]);
            oacc2[4 * d + 3] = __builtin_elementwise_fma(a2, __builtin_amdgcn_cvt_scalef32_pk_f32_fp4(wv[d], 1.0f, 3), oacc2[4 * d + 3]);
          }
        }
      };
      {
        uint2 urA[NSL][3], urB[NSL][3];
        uint4 vrA[NSL], vrB[NSL];
        float gA[NSL], gB[NSL];
        rows_load(urA, vrA, gA, 0);
#pragma unroll 1
        for (int pp = 0; pp < 128; pp += 4 * NSL) {
          rows_load(urB, vrB, gB, pp + 2 * NSL);
          rows_use(urA, vrA, gA);
          if (pp + 4 * NSL < 128) rows_load(urA, vrA, gA, pp + 4 * NSL);
          rows_use(urB, vrB, gB);
        }
      }
#undef NSL
      float oacc[32];
#pragma unroll
      for (int j = 0; j < 32; j++) {
        const float v = oacc2[j >> 1][j & 1];
        oacc[j] = v + __shfl_xor(v, 32, 64);
      }
      float hv[32];
      float ss = 0.f;
      float* hrow = p.out + (size_t)t * 1024 + 32 * ck;
      if (half == 0) {
        float on[32];
#pragma unroll
        for (int j = 0; j < 32; j++) on[j] = oacc[j] * 0.25f;
#pragma unroll
        for (int i = 0; i < 8; i++) {
          float4 v4 = *(const float4*)(hrow + 4 * i);
          hv[4 * i + 0] = v4.x + on[4 * i + 0];
          hv[4 * i + 1] = v4.y + on[4 * i + 1];
          hv[4 * i + 2] = v4.z + on[4 * i + 2];
          hv[4 * i + 3] = v4.w + on[4 * i + 3];
        }
#pragma unroll
        for (int j = 0; j < 32; j++) ss += hv[j] * hv[j];
      } else {
#pragma unroll
        for (int j = 0; j < 32; j++) hv[j] = 0.f;
      }
      ss = wave_sum(ss);
      const float inv = rsqrtf(ss * (1.f / 1024.f) + 1e-6f);
      if (half == 0) {
#pragma unroll
        for (int i = 0; i < 8; i++) {
          float4 gg = *(const float4*)(fng + 32 * ck + 4 * i);
          *(float4*)(hrow + 4 * i) = make_float4(hv[4 * i] * inv * gg.x, hv[4 * i + 1] * inv * gg.y, hv[4 * i + 2] * inv * gg.z, hv[4 * i + 3] * inv * gg.w);
        }
      }
    }
  }
}

#define XB_TMO      128
#define XB_XCNT(j)  (256  + 64 * (j))
#define XB_XSUB(j)  (1280 + 64 * (j))
#define XB_XGEN(j)  (2304 + 64 * (j))
#define XB_TOP      3328
#define XB_TOPGEN   3392
#define XCD_BAR_WORDS 3456
#define XB_SPIN_CAP (1u << 22)
__device__ __forceinline__ unsigned xb_ld(unsigned* p) { return __hip_atomic_load(p, __ATOMIC_RELAXED, __HIP_MEMORY_SCOPE_AGENT); }
__device__ __forceinline__ unsigned xb_add(unsigned* p, unsigned v) { return __hip_atomic_fetch_add(p, v, __ATOMIC_RELAXED, __HIP_MEMORY_SCOPE_AGENT); }
__device__ __forceinline__ unsigned xb_xcc_id() { return (unsigned)__builtin_amdgcn_s_getreg((3 << 11) | 20) & 0xFu; }
#define XB_SPIN(cond, bar) do { unsigned _sp = 0; while (cond) { __builtin_amdgcn_s_sleep(1); \
    if ((++_sp & 255u) == 0u) { if (xb_ld(&(bar)[XB_TMO])) break; if (_sp > XB_SPIN_CAP) { atomicAdd(&(bar)[XB_TMO], 1u); break; } } } } while (0)
struct XcdBarrier { unsigned* bar; unsigned x; volatile LAS unsigned* st; };
__device__ __forceinline__ XcdBarrier xcd_barrier_post(unsigned* bar, volatile LAS unsigned* st) {
  XcdBarrier b; b.bar = bar; b.x = xb_xcc_id(); b.st = st;
  if (threadIdx.x == 0) (void)xb_add(&bar[XB_XCNT(b.x)], 1u);
  return b;
}
__device__ __forceinline__ void xcd_barrier_complete(unsigned* bar, unsigned x, unsigned& nloc, unsigned& nx) {
  const unsigned G = gridDim.x * gridDim.y * gridDim.z;
  unsigned sum, cnt, mine, sp = 0u;
  for (;;) {
    sum = 0u; cnt = 0u; mine = 0u;
#pragma unroll
    for (unsigned j = 0; j < 16; ++j) { const unsigned c = xb_ld(&bar[XB_XCNT(j)]); sum += c; cnt += (c > 0u) ? 1u : 0u; mine = (j == x) ? c : mine; }
    if (sum == G) break;
    __builtin_amdgcn_s_sleep(1);
    if ((++sp & 255u) == 0u) { if (xb_ld(&bar[XB_TMO])) break; if (sp > XB_SPIN_CAP) { atomicAdd(&bar[XB_TMO], 1u); break; } }
  }
  nloc = mine > 0u ? mine : 1u; nx = cnt > 0u ? cnt : 1u;
}
__device__ __forceinline__ void xcd_barrier(const XcdBarrier& b) {
  asm volatile("s_waitcnt vmcnt(0)" ::: "memory");
  __syncthreads();
  if (threadIdx.x == 0) {
    unsigned* bar = b.bar;
    __builtin_amdgcn_s_waitcnt(0);
    unsigned nloc = b.st[0], nx = b.st[1];
    if (nloc == 0u) { xcd_barrier_complete(bar, b.x, nloc, nx); b.st[0] = nloc; b.st[1] = nx; }
    const unsigned old = xb_add(&bar[XB_XSUB(b.x)], 1u);
    const unsigned gen = old / nloc;
    if (old + 1u == (gen + 1u) * nloc) {
      __builtin_amdgcn_fence(__ATOMIC_RELEASE, "agent");
      asm volatile("s_waitcnt vmcnt(0)" ::: "memory");
      const unsigned og = xb_add(&bar[XB_TOP], 1u);
      const unsigned tg = og / nx;
      if (og + 1u == (tg + 1u) * nx) xb_add(&bar[XB_TOPGEN], 1u);
      else XB_SPIN(xb_ld(&bar[XB_TOPGEN]) == tg, bar);
      __builtin_amdgcn_fence(__ATOMIC_ACQUIRE, "agent");
      xb_add(&bar[XB_XGEN(b.x)], 1u);
      asm volatile("s_waitcnt vmcnt(0)" ::: "memory");
    } else {
      XB_SPIN(xb_ld(&bar[XB_XGEN(b.x)]) == gen, bar);
      __builtin_amdgcn_fence(__ATOMIC_ACQUIRE, "agent");
      asm volatile("s_waitcnt vmcnt(0)" ::: "memory");
    }
  }
  __syncthreads();
}

#define OFF_BAR (244 * MB)
__global__ void __launch_bounds__(256, 2) k_mega(Params p) {
  __shared__ __attribute__((aligned(16))) char smem[SMEM_BYTES];
  cg::grid_group grid = cg::this_grid();
  volatile LAS unsigned* xbw = (volatile LAS unsigned*)(smem + SMEM_BYTES - 16);
  if (threadIdx.x == 0) { xbw[0] = 0u; xbw[1] = 0u; xbw[2] = 0u; xbw[3] = 0u; }
  __syncthreads();
  XcdBarrier xb = xcd_barrier_post((unsigned*)(p.ws + OFF_BAR), xbw);
  if (p.ws == nullptr) grid.sync();
  phase0(p, smem); xcd_barrier(xb);
  phase1(p, smem); xcd_barrier(xb);
  phase2(p, smem); xcd_barrier(xb);
  phase4(p, smem); xcd_barrier(xb);
  phase4b(p, smem);
  __syncthreads();
  phase5(p, smem); xcd_barrier(xb);
  phase6(p, smem); xcd_barrier(xb);
  phase8(p, smem); xcd_barrier(xb);
  phase9(p, smem);
}

extern "C" void kernel_launch(void* const* d_in, const int* in_sizes, int n_in, void* d_out, int out_size,
                              void* d_ws, size_t ws_size, hipStream_t stream) {
  Params p{};
  for (int i = 0; i < 26; i++) p.in[i] = (const float*)d_in[i];
  p.out = (float*)d_out;
  p.ws = (char*)d_ws;
  static int grid_blocks = 0;
  if (!grid_blocks) {
    int dev = 0, cus = 0, per_cu = 0;
    (void)hipGetDevice(&dev);
    (void)hipDeviceGetAttribute(&cus, hipDeviceAttributeMultiprocessorCount, dev);
    (void)hipOccupancyMaxActiveBlocksPerMultiprocessor(&per_cu, k_mega, 256, 0);
    if (per_cu > 2) per_cu = 2;
    if (per_cu < 1) per_cu = 1;
    grid_blocks = cus * per_cu;
  }
  (void)hipMemsetAsync((char*)d_ws + OFF_BAR, 0, 32768, stream);
  void* args[] = {&p};
  hipError_t e = hipLaunchCooperativeKernel((void*)k_mega, dim3(grid_blocks), dim3(256), args, 0, stream);
  if (e != hipSuccess) fprintf(stderr, "cooperative launch failed: %s (grid %d)\n", hipGetErrorString(e), grid_blocks);
}
```

```cpp
#include <hip/hip_runtime.h>
#include <hip/hip_cooperative_groups.h>
#include <cstdio>
#include <cstdint>
#include <type_traits>
namespace cg = cooperative_groups;

#define LAS __attribute__((address_space(3)))
typedef unsigned short bf16_t;
using bf16x8 = __attribute__((ext_vector_type(8))) short;
using f32x4 = __attribute__((ext_vector_type(4))) float;
using u32x4 = __attribute__((ext_vector_type(4))) unsigned int;

#define SEQ 16384
#define DMODEL 1024
#define NEG_INF_F (-1e30f)
#define NPHASE 10
#define SMEM_BYTES 79872

#define MB (1024ull * 1024ull)
#define OFF_UT (0ull)
#define OFF_VT (32 * MB)
#define OFF_W (64 * MB)
#define OFF_WIN (OFF_W)
#define OFF_WGLU (OFF_WIN + 3932160ull)
#define OFF_WOUT (OFF_WGLU + 1048576ull)
#define OFF_WQ (OFF_WOUT + 2097152ull)
#define OFF_W1K (OFF_WQ + 4194304ull)
#define OFF_W1V (OFF_W1K + 524288ull)
#define OFF_W2K (OFF_W1V + 524288ull)
#define OFF_W2V (OFF_W2K + 16384ull)
#define OFF_BIASK (OFF_W2V + 16384ull)
#define OFF_BIASV (OFF_BIASK + 512ull)
#define OFF_SUBT (OFF_BIASV + 512ull)
#define OFF_LAMB (OFF_SUBT + 65536ull)
#define OFF_LAM64 (OFF_LAMB + 16384ull)
#define OFF_BBAR (OFF_LAM64 + 16384ull)
#define OFF_Z (80 * MB)
#define OFF_Q (112 * MB)
#define OFF_KV (128 * MB)
#define KV_STRIDE (4 * MB)
#define OFF_U (152 * MB)
#define OFF_MIX (184 * MB)
#define OFF_GATES (216 * MB)
#define OFF_KC (OFF_GATES + 1572864ull)
#define OFF_VC (OFF_KC + 262144ull)
#define OFF_HID (218 * MB)
#define OFF_E (219 * MB)
#define OFF_CIN (223 * MB)
#define OFF_YG (227 * MB)
#define OFF_WQB (OFF_YG)
#define OFF_SM (OFF_MIX)
#define OFF_SQ (OFF_MIX + 24 * MB)
#define OFF_CINB (OFF_CIN)
#define OFF_KT (OFF_CIN + 2 * MB)
#define OFF_UB (OFF_MIX + 8 * MB)
#define OFF_SSQ OFF_E
#define OFF_PQ (112 * MB)

struct Params {
  const float* in[26];
  float* out;
  char* ws;
};

__device__ __forceinline__ int get_tid() {
  int t = threadIdx.x;
  asm volatile("" : "+v"(t));
  return t;
}
__device__ __forceinline__ bf16_t f2bf(float f) {
  unsigned u = __float_as_uint(f);
  u += 0x7FFFu + ((u >> 16) & 1u);
  return (bf16_t)(u >> 16);
}
__device__ __forceinline__ float bf2f(bf16_t b) { return __uint_as_float(((unsigned)b) << 16); }
__device__ __forceinline__ float bflo(unsigned w) { return __uint_as_float(w << 16); }
__device__ __forceinline__ float bfhi(unsigned w) { return __uint_as_float(w & 0xFFFF0000u); }
typedef __bf16 bf16v2_t __attribute__((ext_vector_type(2)));
typedef float f32v2_t __attribute__((ext_vector_type(2)));
__device__ __forceinline__ unsigned pack2(float a, float b) {
  f32v2_t v = {a, b};
  return __builtin_bit_cast(unsigned, __builtin_convertvector(v, bf16v2_t));
}

__device__ __forceinline__ float gelu_tanh(float x) {
  const float u2 = 2.f * 0.7978845608028654f * (x + 0.044715f * x * x * x);
  return x * __builtin_amdgcn_rcpf(1.f + __builtin_amdgcn_exp2f(-1.4426950408889634f * u2));
}
__device__ __forceinline__ float sigmoid_f(float x) { return __builtin_amdgcn_rcpf(1.f + __builtin_amdgcn_exp2f(-1.4426950408889634f * x)); }

__device__ __forceinline__ float wave_sum(float v) {
  v += __uint_as_float((unsigned)__builtin_amdgcn_update_dpp(0u, __float_as_uint(v), 0x128, 0xF, 0xF, false));
  v += __uint_as_float((unsigned)__builtin_amdgcn_update_dpp(0u, __float_as_uint(v), 0x124, 0xF, 0xF, false));
  v += __uint_as_float((unsigned)__builtin_amdgcn_update_dpp(0u, __float_as_uint(v), 0x122, 0xF, 0xF, false));
  v += __uint_as_float((unsigned)__builtin_amdgcn_update_dpp(0u, __float_as_uint(v), 0x121, 0xF, 0xF, false));
  v += __shfl_xor(v, 16, 64);
  v += __shfl_xor(v, 32, 64);
  return v;
}
__device__ __forceinline__ float wave_max(float v) {
#pragma unroll
  for (int o = 32; o > 0; o >>= 1) v = fmaxf(v, __shfl_xor(v, o, 64));
  return v;
}
__device__ __forceinline__ void wave_argmax(float& v, int& i) {
#pragma unroll
  for (int o = 32; o > 0; o >>= 1) {
    float ov = __shfl_xor(v, o, 64);
    int oi = __shfl_xor(i, o, 64);
    if (ov > v || (ov == v && oi < i)) { v = ov; i = oi; }
  }
}
__device__ __forceinline__ void wave_lds_sync() { asm volatile("s_waitcnt lgkmcnt(0)" ::: "memory"); }

__device__ __forceinline__ void sincos_big(float ang, float& sn, float& cs) {
  double rev = (double)ang * 0.15915494309189535;
  rev -= floor(rev);
  float fr = (float)rev;
  sn = __builtin_amdgcn_sinf(fr);
  cs = __builtin_amdgcn_cosf(fr);
}
__device__ __forceinline__ float rope_inv(int i) {
  return exp2f(-(float)i * 2.36644607f);
}

template <int BMODE = 0, bool ZERO = true, int AMODE = 0>
__device__ __forceinline__ void gemm_tile_128(const bf16_t* __restrict__ A, long lda, int M,
                                              const bf16_t* __restrict__ Bt, long ldb, int N, int K,
                                              int row0, int col0, char* smem, f32x4 (&acc)[4][4]) {
  bf16_t(*sA)[72] = (bf16_t(*)[72])smem;
  bf16_t(*sB)[72] = (bf16_t(*)[72])(smem + 128 * 72 * 2);
  const int tid = get_tid(), lane = tid & 63, wid = tid >> 6;
  const int wr = wid >> 1, wc = wid & 1;
  if (ZERO) {
#pragma unroll
    for (int i = 0; i < 4; i++)
#pragma unroll
      for (int j = 0; j < 4; j++) acc[i][j] = (f32x4){0.f, 0.f, 0.f, 0.f};
  }
  const int lr = tid >> 3;
  const int lc = (tid & 7) * 8;
  u32x4 ra[4], rb[4];
  const u32x4 z4 = {0u, 0u, 0u, 0u};
  const bf16_t* pa[4];
  const bf16_t* pb[4];
  bool va[4], vb[4];
  int klim[4];
#pragma unroll
  for (int i = 0; i < 4; i++) {
    int r = lr + 32 * i;
    va[i] = (row0 + r < M);
    vb[i] = (col0 + r < N);
    if (AMODE == 0) pa[i] = A + (long)min(row0 + r, M - 1) * lda + lc;
    else pa[i] = A + ((long)(lc >> 4) * SEQ + min(row0 + r, M - 1)) * 16 + (lc & 15);
    if (BMODE == 0) {
      pb[i] = Bt + (long)min(col0 + r, N - 1) * ldb + lc;
      klim[i] = 0;
    } else {
      const int n = col0 + r, t = n >> 4, ch = n & 15;
      pb[i] = Bt + ((long)(t - (lc >> 4)) * 16 + ch) * 16 + (lc & 15);
      klim[i] = (t + 1) * 16 - lc;
    }
  }
  u32x4 rc[4], rd[4];
  auto gload = [&](u32x4 (&xa)[4], u32x4 (&xb)[4], int k) __attribute__((always_inline)) {
#pragma unroll
    for (int i = 0; i < 4; i++) {
      u32x4 x = *(const u32x4*)(pa[i] + ((AMODE == 0) ? (long)k : (long)k * SEQ));
      xa[i] = va[i] ? x : z4;
      if (BMODE == 0) {
        u32x4 y = *(const u32x4*)(pb[i] + k);
        xb[i] = vb[i] ? y : z4;
      } else {
        const bool ok = k < klim[i];
        u32x4 y = *(const u32x4*)(ok ? pb[i] - 16 * (long)k : Bt);
        xb[i] = ok ? y : z4;
      }
    }
  };
  auto lstore = [&](const u32x4 (&xa)[4], const u32x4 (&xb)[4], int buf) __attribute__((always_inline)) {
    bf16_t(*nA)[72] = (bf16_t(*)[72])(smem + buf * 36864);
    bf16_t(*nB)[72] = (bf16_t(*)[72])(smem + buf * 36864 + 18432);
#pragma unroll
    for (int i = 0; i < 4; i++) {
      int r = lr + 32 * i;
      *(u32x4*)&nA[r][lc] = xa[i];
      *(u32x4*)&nB[r][lc] = xb[i];
    }
  };
  auto compute = [&](int buf) __attribute__((always_inline)) {
    bf16_t(*cA)[72] = (bf16_t(*)[72])(smem + buf * 36864);
    bf16_t(*cB)[72] = (bf16_t(*)[72])(smem + buf * 36864 + 18432);
#pragma unroll
    for (int ks = 0; ks < 2; ks++) {
      bf16x8 af[4], bfr[4];
#pragma unroll
      for (int i = 0; i < 4; i++) af[i] = *(const bf16x8*)&cA[wr * 64 + i * 16 + (lane & 15)][ks * 32 + (lane >> 4) * 8];
#pragma unroll
      for (int j = 0; j < 4; j++) bfr[j] = *(const bf16x8*)&cB[wc * 64 + j * 16 + (lane & 15)][ks * 32 + (lane >> 4) * 8];
#pragma unroll
      for (int i = 0; i < 4; i++)
#pragma unroll
        for (int j = 0; j < 4; j++) acc[i][j] = __builtin_amdgcn_mfma_f32_16x16x32_bf16(af[i], bfr[j], acc[i][j], 0, 0, 0);
    }
  };
  gload(ra, rb, 0);
  if (64 < K) gload(rc, rd, 64);
  __syncthreads();
  lstore(ra, rb, 0);
  if (128 < K) gload(ra, rb, 128);
  for (int k0 = 0; k0 < K; k0 += 128) {
    __syncthreads();
    if (k0 + 64 < K) lstore(rc, rd, 1);
    if (k0 + 192 < K) gload(rc, rd, k0 + 192);
    compute(0);
    if (k0 + 64 < K) {
      __syncthreads();
      if (k0 + 128 < K) lstore(ra, rb, 0);
      if (k0 + 256 < K) gload(ra, rb, k0 + 256);
      compute(1);
    }
  }
  __syncthreads();
}

#define EPI_LD 68
__device__ __forceinline__ float* stage_acc(const f32x4 (&acc)[4][4], char* smem) {
  const int lane = get_tid() & 63, wid = get_tid() >> 6;
  float* t = (float*)(smem + wid * (64 * EPI_LD * 4));
  const int q = lane >> 4, c = lane & 15;
#pragma unroll
  for (int i = 0; i < 4; i++)
#pragma unroll
    for (int j = 0; j < 4; j++)
#pragma unroll
      for (int jj = 0; jj < 4; jj++) t[(i * 16 + q * 4 + jj) * EPI_LD + j * 16 + c] = acc[i][j][jj];
  wave_lds_sync();
  return t;
}

__device__ __forceinline__ void transpose_job_w(const float* __restrict__ src, int Ksrc, int Nsrc, bf16_t* __restrict__ dst, int Ndst,
                                                int perm, int tile, char* smem) {
  float(*t)[33] = (float(*)[33])smem;
  const int tiles_k = Ksrc / 128;
  const int tn = tile / tiles_k, tk = tile % tiles_k;
  const int tid = get_tid();
  __syncthreads();
  for (int e = tid; e < 128 * 32; e += 256) {
    int kk = e >> 5, nn = e & 31;
    int n = tn * 32 + nn;
    int oc;
    if (perm == 1) {
      oc = (n < 1280) ? n : (n < 1792 ? 1304 + (n - 1280) : (n < 1816 ? 1280 + (n - 1792) : -1));
    } else if (perm == 2) {
      int b64 = n >> 6, w = n & 63;
      oc = (w < 32) ? (32 * b64 + w) : (512 + 32 * b64 + (w - 32));
    } else {
      oc = (n < Nsrc) ? n : -1;
    }
    float v = 0.f;
    if (oc >= 0) v = src[(size_t)(tk * 128 + kk) * Nsrc + oc];
    t[kk][nn] = v;
  }
  __syncthreads();
  for (int e = tid; e < 128 * 32; e += 256) {
    int nn = e >> 7, kk = e & 127;
    dst[(size_t)(tn * 32 + nn) * Ksrc + tk * 128 + kk] = f2bf(t[kk][nn]);
  }
}
__device__ __forceinline__ void transpose_job(const float* __restrict__ src, int Ksrc, int Nsrc, bf16_t* __restrict__ dst, int Ndst,
                              int perm, int tile, char* smem) {
  float(*t)[65] = (float(*)[65])smem;
  const int tiles_k = Ksrc / 64;
  const int tn = tile / tiles_k, tk = tile % tiles_k;
  const int tid = get_tid();
  __syncthreads();
  for (int e = tid; e < 64 * 64; e += 256) {
    int kk = e >> 6, nn = e & 63;
    int n = tn * 64 + nn;
    int oc;
    if (perm == 1) {
      oc = (n < 1280) ? n : (n < 1792 ? 1304 + (n - 1280) : (n < 1816 ? 1280 + (n - 1792) : -1));
    } else if (perm == 2) {
      int b64 = n >> 6, w = n & 63;
      oc = (w < 32) ? (32 * b64 + w) : (512 + 32 * b64 + (w - 32));
    } else {
      oc = (n < Nsrc) ? n : -1;
    }
    float v = 0.f;
    if (oc >= 0) v = src[(size_t)(tk * 64 + kk) * Nsrc + oc];
    t[kk][nn] = v;
  }
  __syncthreads();
  for (int e = tid; e < 64 * 64; e += 256) {
    int nn = e >> 6, kk = e & 63;
    dst[(size_t)(tn * 64 + nn) * Ksrc + tk * 64 + kk] = f2bf(t[kk][nn]);
  }
}

__device__ __forceinline__ void phase0(const Params& p, char* smem) {
  const int tid = get_tid(), lane = tid & 63, wid = tid >> 6;
  const int gw = blockIdx.x * 4 + wid, nw = gridDim.x * 4;
  char* ws = p.ws;
  {
    const float* x = p.in[0];
    const float* g = p.in[1];
    bf16_t* z = (bf16_t*)(ws + OFF_Z);
    for (int r = gw; r < SEQ; r += nw) {
      const float4* src = (const float4*)(x + (size_t)r * 1024);
      float4 v[4];
      float ss = 0.f;
#pragma unroll
      for (int i = 0; i < 4; i++) {
        v[i] = src[lane + 64 * i];
        ss += v[i].x * v[i].x + v[i].y * v[i].y + v[i].z * v[i].z + v[i].w * v[i].w;
      }
      ss = wave_sum(ss);
      float inv = rsqrtf(ss * (1.f / 1024.f) + 1e-6f);
#pragma unroll
      for (int i = 0; i < 4; i++) {
        float4 gg = ((const float4*)g)[lane + 64 * i];
        uint2 o;
        o.x = pack2(v[i].x * inv * gg.x, v[i].y * inv * gg.y);
        o.y = pack2(v[i].z * inv * gg.z, v[i].w * inv * gg.w);
        *(uint2*)(z + (size_t)r * 1024 + (lane + 64 * i) * 4) = o;
      }
    }
  }
  {
    for (int j = blockIdx.x; j < 480; j += gridDim.x) transpose_job_w(p.in[2], 1024, 1816, (bf16_t*)(ws + OFF_WIN), 1920, 1, j, smem);
  }
  {
    const float4* src = (const float4*)p.in[20];
    uint2* dst = (uint2*)(ws + OFF_WQB);
    for (int i = blockIdx.x * 256 + tid; i < 1024 * 2048 / 4; i += gridDim.x * 256) {
      const float4 v = src[i];
      const float gk = p.in[19][i >> 9];
      dst[i] = make_uint2(pack2(v.x * gk, v.y * gk), pack2(v.z * gk, v.w * gk));
    }
  }
  {
    bf16_t* dst = (bf16_t*)(ws + OFF_SUBT);
    for (int i = blockIdx.x * 256 + tid; i < 2 * 16384; i += gridDim.x * 256) {
      float v = (i < 16384) ? p.in[21][i] : p.in[22][i - 16384];
      dst[i] = f2bf(v);
    }
  }
  {
    bf16_t* SM = (bf16_t*)(ws + OFF_SM);
    for (int idx = blockIdx.x * 256 + tid; idx < 2048 * 64; idx += gridDim.x * 256) {
      const int gs = idx >> 6, t = idx & 63, g = gs >> 6, sidx = gs & 63;
      const float dt = expf(p.in[11][g]);
      const float lr = p.in[9][gs], li = p.in[10][gs];
      const float ang = li * dt;
      float sn, cs;
      sincos_big(ang, sn, cs);
      const float em1 = expm1f(lr * dt);
      const float mag = em1 + 1.f;
      float sh, ch;
      sincos_big(0.5f * ang, sh, ch);
      const float a = em1 * cs - 2.f * sh * sh;
      const float b = mag * sn;
      const float den = lr * lr + li * li;
      const float cr = (a * lr + b * li) / den;
      const float ci = (b * lr - a * li) / den;
      const float pw = (float)(63 - t);
      float snp, csp;
      sincos_big(pw * ang, snp, csp);
      const float mp = expf(pw * lr * dt);
      const float fx = mp * (csp * cr - snp * ci), fy = mp * (csp * ci + snp * cr);
      const float* bre = p.in[12] + (size_t)gs * 16;
      const float* bim = p.in[13] + (size_t)gs * 16;
      unsigned wre[8], wim[8];
#pragma unroll
      for (int c = 0; c < 8; c++) {
        const float xr0 = bre[2 * c], xi0 = bim[2 * c], xr1 = bre[2 * c + 1], xi1 = bim[2 * c + 1];
        wre[c] = pack2(fx * xr0 - fy * xi0, fx * xr1 - fy * xi1);
        wim[c] = pack2(fx * xi0 + fy * xr0, fx * xi1 + fy * xr1);
      }
      bf16_t* dre = SM + ((size_t)(g * 128 + sidx)) * 1024 + t * 16;
      bf16_t* dim = dre + (size_t)64 * 1024;
      *(uint4*)dre = make_uint4(wre[0], wre[1], wre[2], wre[3]);
      *(uint4*)(dre + 8) = make_uint4(wre[4], wre[5], wre[6], wre[7]);
      *(uint4*)dim = make_uint4(wim[0], wim[1], wim[2], wim[3]);
      *(uint4*)(dim + 8) = make_uint4(wim[4], wim[5], wim[6], wim[7]);
    }
  }
  {
    for (int gt = (((int)blockIdx.x + (int)gridDim.x - (256 % (int)gridDim.x)) % (int)gridDim.x) * 256 + tid; gt < 2048; gt += (int)gridDim.x * 256) {
      const int g = gt >> 6;
      const float dt = expf(p.in[11][g]);
      const float lr = p.in[9][gt], li = p.in[10][gt];
      float sn64, cs64;
      sincos_big(64.f * li * dt, sn64, cs64);
      const float m64 = expf(64.f * lr * dt);
      ((float2*)(ws + OFF_LAM64))[gt] = make_float2(m64 * cs64, m64 * sn64);
    }
  }
}

__device__ __forceinline__ void side_jobs(const Params& p, char* smem, int b0, int nb) {
  const int tid = get_tid(), lane = tid & 63, wid = tid >> 6;
  char* ws = p.ws;
  for (int j = b0; j < 132; j += nb) {
    if (j < 64) transpose_job_w(p.in[4], 2048, 128, (bf16_t*)(ws + OFF_W1K), 128, 0, j, smem);
    else if (j < 128) transpose_job_w(p.in[7], 2048, 128, (bf16_t*)(ws + OFF_W1V), 128, 0, j - 64, smem);
    else if (j < 130) transpose_job_w(p.in[5], 128, 64, (bf16_t*)(ws + OFF_W2K), 64, 0, j - 128, smem);
    else transpose_job_w(p.in[8], 128, 64, (bf16_t*)(ws + OFF_W2V), 64, 0, j - 130, smem);
  }
  {
    for (int o8 = b0 * 4 + wid; o8 < 32; o8 += nb * 4) {
      const int kv = o8 >> 4, j0 = (o8 & 15) * 8;
      const float* pe = kv ? p.in[6] : p.in[3];
      const float* w1 = kv ? p.in[7] : p.in[4];
      float a[8];
#pragma unroll
      for (int c = 0; c < 8; c++) a[c] = 0.f;
      for (int i = lane; i < 2048; i += 64) {
        const float pv = pe[i];
        const float4 w0 = *(const float4*)(w1 + (size_t)i * 128 + j0), w4 = *(const float4*)(w1 + (size_t)i * 128 + j0 + 4);
        a[0] += pv * w0.x; a[1] += pv * w0.y; a[2] += pv * w0.z; a[3] += pv * w0.w;
        a[4] += pv * w4.x; a[5] += pv * w4.y; a[6] += pv * w4.z; a[7] += pv * w4.w;
      }
#pragma unroll
      for (int c = 0; c < 8; c++) a[c] = wave_sum(a[c]);
      if (lane == 0) {
        float* dst = (float*)(ws + (kv ? OFF_BIASV : OFF_BIASK)) + j0;
        *(float4*)dst = make_float4(a[0], a[1], a[2], a[3]);
        *(float4*)(dst + 4) = make_float4(a[4], a[5], a[6], a[7]);
      }
    }
  }
}

__device__ __forceinline__ void phase1(const Params& p, char* smem) {
  char* ws = p.ws;
  const bf16_t* Z = (const bf16_t*)(ws + OFF_Z);
  const bf16_t* W = (const bf16_t*)(ws + OFF_WIN);
  bf16_t* Q = (bf16_t*)(ws + OFF_Q);
  float* GATES = (float*)(ws + OFF_GATES);
  const int lane = get_tid() & 63, wid = get_tid() >> 6, wr = wid >> 1, wc = wid & 1;
  for (int tile = blockIdx.x; tile < 128 * 15; tile += gridDim.x) {
    const int tm = tile / 15, tn = tile % 15;
    f32x4 acc[4][4];
    gemm_tile_128(Z, 1024, SEQ, W, 1024, 1920, 1024, tm * 128, tn * 128, smem, acc);
    const int sp = tn * 2 + wc;
    const int prow0 = tm * 128 + wr * 64;
    if (sp == 14 || sp == 15) {
      unsigned char* dst = (unsigned char*)(ws + OFF_KV + 3 * KV_STRIDE);
      const int hd = sp - 14;
#pragma unroll
      for (int j = 0; j < 4; j++) {
        const int d = j * 16 + (lane & 15);
#pragma unroll
        for (int i = 0; i < 4; i++) {
          const int pos0 = prow0 + i * 16 + (lane >> 4) * 4;
          int w = __builtin_amdgcn_cvt_pk_fp8_f32(acc[i][j][0] * 8.f, acc[i][j][1] * 8.f, 0, false);
          w = __builtin_amdgcn_cvt_pk_fp8_f32(acc[i][j][2] * 8.f, acc[i][j][3] * 8.f, w, true);
          *(int*)(dst + (((size_t)hd * 256 + (pos0 >> 6)) * 64 + d) * 64 + (pos0 & 63)) = w;
        }
      }
    } else if (sp == 18 || sp == 19) {
      const int hd = sp - 18;
#pragma unroll
      for (int j = 0; j < 4; j++) {
        const int d = j * 16 + (lane & 15);
        bf16_t* dst = (bf16_t*)(ws + OFF_KV + 5 * KV_STRIDE) + ((size_t)hd * 64 + d) * SEQ;
#pragma unroll
        for (int i = 0; i < 4; i++) {
          const int pos0 = prow0 + i * 16 + (lane >> 4) * 4;
          uint2 w;
          w.x = pack2(acc[i][j][0], acc[i][j][1]);
          w.y = pack2(acc[i][j][2], acc[i][j][3]);
          *(uint2*)(dst + pos0) = w;
        }
      }
    }
    {
      const float* t = stage_acc(acc, smem);
      const int rs = lane >> 3, ch = lane & 7;
      const bool is_q = sp < 8;
      const bool ropes = is_q || sp == 12 || sp == 13 || sp == 16 || sp == 17;
      const bool rowsec = (sp <= 13) || sp == 16 || sp == 17 || (sp >= 20 && sp <= 28);
      if (rowsec) {
#pragma unroll 2
        for (int it = 0; it < 8; it++) {
          const int r = it * 8 + rs;
          const int pos = prow0 + r;
          const float* tr = t + r * EPI_LD + 8 * ch;
          float4 a0 = *(const float4*)tr, a1 = *(const float4*)(tr + 4);
          float v[8] = {a0.x, a0.y, a0.z, a0.w, a1.x, a1.y, a1.z, a1.w};
          if (ropes && ch < 2) {
            const float* tp = t + r * EPI_LD + 8 * (ch ^ 1);
            float4 b0 = *(const float4*)tp, b1 = *(const float4*)(tp + 4);
            const float pv[8] = {b0.x, b0.y, b0.z, b0.w, b1.x, b1.y, b1.z, b1.w};
            const float sgn = (ch == 0) ? -1.f : 1.f;
#pragma unroll
            for (int i = 0; i < 8; i++) {
              float sn, cs;
              sincos_big((float)pos * rope_inv(i), sn, cs);
              v[i] = v[i] * cs + sgn * pv[i] * sn;
            }
          }
          if (is_q) {
            uint4 w;
            w.x = pack2(v[0] * 0.125f, v[1] * 0.125f); w.y = pack2(v[2] * 0.125f, v[3] * 0.125f);
            w.z = pack2(v[4] * 0.125f, v[5] * 0.125f); w.w = pack2(v[6] * 0.125f, v[7] * 0.125f);
            *(uint4*)(Q + ((size_t)pos * 8 + sp) * 64 + 8 * ch) = w;
          } else if (sp == 12 || sp == 13) {
            int w0 = __builtin_amdgcn_cvt_pk_fp8_f32(v[0] * 8.f, v[1] * 8.f, 0, false);
            w0 = __builtin_amdgcn_cvt_pk_fp8_f32(v[2] * 8.f, v[3] * 8.f, w0, true);
            int w1 = __builtin_amdgcn_cvt_pk_fp8_f32(v[4] * 8.f, v[5] * 8.f, 0, false);
            w1 = __builtin_amdgcn_cvt_pk_fp8_f32(v[6] * 8.f, v[7] * 8.f, w1, true);
            unsigned char* dst8 = (unsigned char*)(ws + OFF_KV + 2 * KV_STRIDE);
            *(uint2*)(dst8 + ((size_t)(sp - 12) * SEQ + pos) * 64 + 8 * ch) = make_uint2((unsigned)w0, (unsigned)w1);
          } else if (sp <= 17) {
            const int sec = (sp >= 16) ? 4 : ((sp - 8) >> 1);
            const int g = sp & 1;
            uint4 w;
            w.x = pack2(v[0], v[1]); w.y = pack2(v[2], v[3]); w.z = pack2(v[4], v[5]); w.w = pack2(v[6], v[7]);
            bf16_t* dst = (bf16_t*)(ws + OFF_KV + (size_t)sec * KV_STRIDE);
            *(uint4*)(dst + ((size_t)g * SEQ + pos) * 64 + 8 * ch) = w;
          } else if (sp <= 27) {
            {
              const int ug = (sp - 20) * 4 + (ch >> 1);
              uint4 w;
              w.x = pack2(v[0], v[1]); w.y = pack2(v[2], v[3]); w.z = pack2(v[4], v[5]); w.w = pack2(v[6], v[7]);
              *(uint4*)((bf16_t*)(ws + OFF_UB) + ((size_t)(ug * 256 + (pos >> 6)) * 64 + (pos & 63)) * 16 + (ch & 1) * 8) = w;
            }
          } else if (ch < 3) {
            float* dst = GATES + (size_t)pos * 24 + 8 * ch;
            *(float4*)dst = make_float4(sigmoid_f(v[0]), sigmoid_f(v[1]), sigmoid_f(v[2]), sigmoid_f(v[3]));
            *(float4*)(dst + 4) = make_float4(sigmoid_f(v[4]), sigmoid_f(v[5]), sigmoid_f(v[6]), sigmoid_f(v[7]));
          }
        }
      }
      __syncthreads();
    }
  }
  {
    const int G = (int)gridDim.x;
    const int rounds = (128 * 15 + G - 1) / G;
    const int idle_first = 128 * 15 - (rounds - 1) * G;
    int nb = G - idle_first, b0 = (int)blockIdx.x - idle_first;
    if (nb <= 0) { nb = G; b0 = (int)blockIdx.x; }
    if (b0 >= 0) side_jobs(p, smem, b0, nb);
  }
}


#define OFF_WQ_SSM3 (244 * MB + 16384 + 2048)
typedef float v32f_t __attribute__((ext_vector_type(32)));
typedef float v16f_t __attribute__((ext_vector_type(16)));
typedef unsigned v6u_t __attribute__((ext_vector_type(6)));
#ifndef FP6_INTERLEAVED
#define FP6_INTERLEAVED 1
#endif
#define FP6_COL(j) (FP6_INTERLEAVED ? ((((j) & 1) << 4) | ((j) >> 1)) : (j))
__device__ __forceinline__ void convert_item(const Params& p, int item) {
  char* ws = p.ws;
  const int tid = get_tid();
  {
    const int tb = item >> 7;
    const float4* src = (const float4*)(tb ? p.in[24] : p.in[23]);
    unsigned char* dst = (unsigned char*)(ws + OFF_UT);
    const float sc = tb ? 4.f : 64.f;
    const float cl = tb ? 6.f : 7.5f;
    const size_t c0 = (size_t)(item & 127) * 4096 + tid;
#pragma unroll 2
    for (size_t c = c0; c < c0 + 4096; c += 256) {
      v16f_t x, y;
#pragma unroll
      for (int i = 0; i < 4; i++) {
        float4 a = src[c * 8 + i], b2 = src[c * 8 + 4 + i];
        x[4 * i + 0] = fminf(fmaxf(a.x * sc, -cl), cl);
        x[4 * i + 1] = fminf(fmaxf(a.y * sc, -cl), cl);
        x[4 * i + 2] = fminf(fmaxf(a.z * sc, -cl), cl);
        x[4 * i + 3] = fminf(fmaxf(a.w * sc, -cl), cl);
        y[4 * i + 0] = fminf(fmaxf(b2.x * sc, -cl), cl);
        y[4 * i + 1] = fminf(fmaxf(b2.y * sc, -cl), cl);
        y[4 * i + 2] = fminf(fmaxf(b2.z * sc, -cl), cl);
        y[4 * i + 3] = fminf(fmaxf(b2.w * sc, -cl), cl);
      }
      const size_t row = c >> 5, ckk = c & 31;
      unsigned char* rb = dst + row * 1280;
      if (tb == 0) {
        v6u_t w = __builtin_amdgcn_cvt_scalef32_2xpk16_fp6_f32(x, y, 1.0f);
        *(uint4*)(rb + 16 * ckk) = make_uint4(w[0], w[1], w[2], w[3]);
        *(uint2*)(rb + 512 + 8 * ckk) = make_uint2(w[4], w[5]);
      } else {
        unsigned w4[4];
#pragma unroll
        for (int d = 0; d < 4; d++) {
          unsigned w = 0u;
          float v8[8];
#pragma unroll
          for (int e = 0; e < 8; e++) v8[e] = (d < 2) ? x[8 * d + e] : y[8 * (d - 2) + e];
          w = __builtin_amdgcn_cvt_scalef32_pk_fp4_f32(w, v8[0], v8[1], 1.0f, 0);
          w = __builtin_amdgcn_cvt_scalef32_pk_fp4_f32(w, v8[2], v8[3], 1.0f, 1);
          w = __builtin_amdgcn_cvt_scalef32_pk_fp4_f32(w, v8[4], v8[5], 1.0f, 2);
          w = __builtin_amdgcn_cvt_scalef32_pk_fp4_f32(w, v8[6], v8[7], 1.0f, 3);
          w4[d] = w;
        }
        *(uint4*)(rb + 768 + 16 * ckk) = make_uint4(w4[0], w4[1], w4[2], w4[3]);
      }
    }
  }
}

__device__ __forceinline__ void dep_wait(unsigned* cnt, unsigned target) {
  if (get_tid() == 0) {
    unsigned sp = 0;
    while (__hip_atomic_load(cnt, __ATOMIC_RELAXED, __HIP_MEMORY_SCOPE_AGENT) < target) {
      __builtin_amdgcn_s_sleep(2);
      if (++sp > (1u << 20)) break;
    }
    __builtin_amdgcn_fence(__ATOMIC_ACQUIRE, "agent");
    asm volatile("s_waitcnt vmcnt(0)" ::: "memory");
  }
  __syncthreads();
}
__device__ __forceinline__ void dep_publish(unsigned* cnt) {
  asm volatile("s_waitcnt vmcnt(0)" ::: "memory");
  __syncthreads();
  if (get_tid() == 0) {
    __builtin_amdgcn_fence(__ATOMIC_RELEASE, "agent");
    asm volatile("s_waitcnt vmcnt(0)" ::: "memory");
    (void)__hip_atomic_fetch_add(cnt, 1u, __ATOMIC_RELAXED, __HIP_MEMORY_SCOPE_AGENT);
  }
}

__device__ __forceinline__ void phase3_task(const Params& p, char* smem, int task) {
  char* ws = p.ws;
  const int lane = get_tid() & 63, wid = get_tid() >> 6, wr = wid >> 1, wc = wid & 1;
  {
    if (task < 32) {
      const int prob = task >> 3, tm = task & 7;
      const int kv = prob >> 1, g = prob & 1;
      const bf16_t* A = (const bf16_t*)(ws + OFF_HID) + (size_t)prob * 1024 * 128;
      const bf16_t* Bt = (const bf16_t*)(ws + (kv ? OFF_W2V : OFF_W2K));
      bf16_t* dst = (bf16_t*)(ws + (kv ? OFF_VC : OFF_KC)) + (size_t)g * 1024 * 64;
      f32x4 acc[4][4];
      gemm_tile_128(A, 128, 1023, Bt, 128, 64, 128, tm * 128, 0, smem, acc);
#pragma unroll
      for (int j = 0; j < 4; j++) {
        const int col = wc * 64 + j * 16 + (lane & 15);
        const bool rope = (kv == 0) && (col < 16);
        const float inv = rope_inv(col & 7);
#pragma unroll
        for (int i = 0; i < 4; i++)
#pragma unroll
          for (int jj = 0; jj < 4; jj++) {
            int row = tm * 128 + wr * 64 + i * 16 + (lane >> 4) * 4 + jj;
            float x = acc[i][j][jj];
            float partner = __shfl_xor(x, 8, 64);
            if (rope) {
              float ang = (float)(row * 16 + 31) * inv;
              float sn, cs;
              sincos_big(ang, sn, cs);
              x = (col < 8) ? (x * cs - partner * sn) : (x * cs + partner * sn);
            }
            if (kv == 0 && row < 1023 && col < 64) dst[(size_t)row * 64 + col] = f2bf(x);
          }
        if (kv == 1 && col < 64) {
#pragma unroll
          for (int i = 0; i < 4; i++) {
            const int row0 = tm * 128 + wr * 64 + i * 16 + (lane >> 4) * 4;
            uint2 w;
            w.x = pack2(acc[i][j][0], acc[i][j][1]);
            w.y = pack2(acc[i][j][2], acc[i][j][3]);
            *(uint2*)(dst + (size_t)col * 1024 + row0) = w;
          }
        }
      }
    } else {
      const int g = task - 32, pp = get_tid() & 63, sg = get_tid() >> 6;
      const float2 l64 = ((const float2*)(ws + OFF_LAM64))[g * 64 + pp];
      const float2* E = (const float2*)(ws + OFF_E) + ((size_t)g * 256 + sg * 64) * 64 + pp;
      bf16_t* CINB = (bf16_t*)(ws + OFF_CINB) + ((size_t)g * 256 + sg * 64) * 128 + pp;
      float2 e[64];
#pragma unroll
      for (int k = 0; k < 64; k++) e[k] = E[(size_t)k * 64];
      float2 t = make_float2(0.f, 0.f);
#pragma unroll
      for (int k = 0; k < 64; k++) {
        float nr = l64.x * t.x - l64.y * t.y + e[k].x;
        float ni = l64.x * t.y + l64.y * t.x + e[k].y;
        t.x = nr;
        t.y = ni;
      }
      float2* sh = (float2*)smem;
      sh[sg * 64 + pp] = t;
      float2 P = l64;
#pragma unroll
      for (int k = 0; k < 6; k++) {
        float nr = P.x * P.x - P.y * P.y;
        float ni = 2.f * P.x * P.y;
        P.x = nr;
        P.y = ni;
      }
      __syncthreads();
      float2 carry = make_float2(0.f, 0.f);
#pragma unroll
      for (int j = 0; j < 3; j++) {
        const float2 tj = sh[j * 64 + pp];
        float nr = P.x * carry.x - P.y * carry.y + tj.x;
        float ni = P.x * carry.y + P.y * carry.x + tj.y;
        if (j < sg) {
          carry.x = nr;
          carry.y = ni;
        }
      }
#pragma unroll
      for (int k = 0; k < 64; k++) {
        CINB[(size_t)k * 128] = f2bf(carry.x);
        CINB[(size_t)k * 128 + 64] = f2bf(carry.y);
        float nr = l64.x * carry.x - l64.y * carry.y + e[k].x;
        float ni = l64.x * carry.y + l64.y * carry.x + e[k].y;
        carry.x = nr;
        carry.y = ni;
      }
      __syncthreads();
    }
  }
}

__device__ __forceinline__ void s5_operator_item(const Params& p, char* smem, int item) {
  char* ws = p.ws;
  const int lane = get_tid() & 63, wid = get_tid() >> 6;
  const int g = item >> 4, d = (item & 15) * 4 + wid;
  float2* Cs = (float2*)smem;
  float2* Gs = (float2*)(smem + 8448 + wid * 8704);
  __syncthreads();
  for (int e = get_tid(); e < 1024; e += 256) Cs[(e >> 6) * 65 + (e & 63)] = make_float2(p.in[14][g * 1024 + e], p.in[15][g * 1024 + e]);
  float2 l1;
  {
    const int gs = g * 64 + lane;
    const float dt = expf(p.in[11][g]);
    const float lr = p.in[9][gs], li = p.in[10][gs];
    const float ang = li * dt;
    float sn, cs;
    sincos_big(ang, sn, cs);
    const float em1 = expm1f(lr * dt);
    const float mag = em1 + 1.f;
    float sh, chh;
    sincos_big(0.5f * ang, sh, chh);
    const float a = em1 * cs - 2.f * sh * sh;
    const float b = mag * sn;
    const float den = lr * lr + li * li;
    const float cr = (a * lr + b * li) / den;
    const float ci = (b * lr - a * li) / den;
    const float pw = (float)d;
    float snd, csd;
    sincos_big(pw * ang, snd, csd);
    const float md = expf(pw * lr * dt);
    const float ldx = md * csd, ldy = md * snd;
    const float fx = ldx * cr - ldy * ci, fy = ldx * ci + ldy * cr;
    l1 = make_float2(ldx * (mag * cs) - ldy * (mag * sn), ldx * (mag * sn) + ldy * (mag * cs));
    const float* bre = p.in[12] + (size_t)gs * 16;
    const float* bim = p.in[13] + (size_t)gs * 16;
#pragma unroll
    for (int c = 0; c < 16; c++) {
      const float xr = bre[c], xi = bim[c];
      Gs[lane * 17 + c] = make_float2(fx * xr - fy * xi, fx * xi + fy * xr);
    }
  }
  __syncthreads();
  {
    bf16_t* Q = (bf16_t*)(ws + OFF_SQ) + ((size_t)g * 1024 + d * 16) * 128;
#pragma unroll 4
    for (int ch = 0; ch < 16; ch++) {
      const float2 cv = Cs[ch * 65 + lane];
      Q[ch * 128 + lane] = f2bf(cv.x * l1.x - cv.y * l1.y);
      Q[ch * 128 + 64 + lane] = f2bf(-(cv.x * l1.y + cv.y * l1.x));
    }
  }
  {
    const int ch = lane >> 2, c4 = (lane & 3) * 4;
    float k0 = 0.f, k1 = 0.f, k2 = 0.f, k3 = 0.f;
#pragma unroll 4
    for (int sidx = 0; sidx < 64; sidx++) {
      const float2 cv = Cs[ch * 65 + sidx];
      const float2 g0 = Gs[sidx * 17 + c4], g1 = Gs[sidx * 17 + c4 + 1], g2 = Gs[sidx * 17 + c4 + 2], g3 = Gs[sidx * 17 + c4 + 3];
      k0 += cv.x * g0.x - cv.y * g0.y;
      k1 += cv.x * g1.x - cv.y * g1.y;
      k2 += cv.x * g2.x - cv.y * g2.y;
      k3 += cv.x * g3.x - cv.y * g3.y;
    }
    bf16_t* KT = (bf16_t*)(ws + OFF_KT) + (((size_t)g * 64 + d) * 16 + ch) * 16 + c4;
    *(uint2*)KT = make_uint2(pack2(k0, k1), pack2(k2, k3));
  }
}
__device__ __forceinline__ void s5_output_tile(const Params& p, char* smem, int item) {
  char* ws = p.ws;
  const int j = 7 - (item >> 6), g = (item & 63) >> 1, m = item & 1;
  f32x4 acc[4][4];
  gemm_tile_128<1, true>((const bf16_t*)(ws + OFF_UB) + (size_t)g * 256 * 1024, 1024, 256, (const bf16_t*)(ws + OFF_KT) + (size_t)g * 64 * 256, 0,
                         1024, 128 * (j + 1), m * 128, j * 128, smem, acc);
  gemm_tile_128<0, false>((const bf16_t*)(ws + OFF_CINB) + (size_t)g * 256 * 128, 128, 256, (const bf16_t*)(ws + OFF_SQ) + (size_t)g * 1024 * 128, 128,
                          1024, 128, m * 128, j * 128, smem, acc);
  const int lane = get_tid() & 63, wid = get_tid() >> 6, wr = wid >> 1, wc = wid & 1;
  const int ch = lane & 15;
  const float dsk = p.in[16][g * 16 + ch];
  const bf16_t* UBg = (const bf16_t*)(ws + OFF_UB) + (size_t)g * 256 * 1024;
  bf16_t* YG = (bf16_t*)(ws + OFF_YG);
#pragma unroll
  for (int i = 0; i < 4; i++)
#pragma unroll
    for (int jj = 0; jj < 4; jj++) {
      const int chunk = m * 128 + wr * 64 + i * 16 + (lane >> 4) * 4 + jj;
#pragma unroll
      for (int jq = 0; jq < 4; jq++) {
        const int t = 8 * j + wc * 4 + jq;
        const float uv = bf2f(UBg[((size_t)chunk * 64 + t) * 16 + ch]);
        YG[((size_t)g * SEQ + (size_t)chunk * 64 + t) * 16 + ch] = f2bf(gelu_tanh(acc[i][jq][jj] + dsk * uv));
      }
    }
}

template <int MODE>
__device__ __forceinline__ void attn_tile_task(const Params& p, int tt, int g, float* impw);
__device__ __forceinline__ void phase2(const Params& p, char* smem) {
  char* ws = p.ws;
  {
    const int G = (int)gridDim.x;
    const int rank = ((G - 33 - (int)blockIdx.x) % G + G) % G;
    const int lane = get_tid() & 63, wid = get_tid() >> 6, wr = wid >> 1, wc = wid & 1;
    for (int et = rank; et < 64; et += G) {
      const int g = et >> 1, half = et & 1;
      f32x4 acc[4][4];
      gemm_tile_128((const bf16_t*)(ws + OFF_SM) + (size_t)g * 128 * 1024, 1024, 128, (const bf16_t*)(ws + OFF_UB) + (size_t)g * 256 * 1024, 1024,
                    256, 1024, 0, half * 128, smem, acc);
      float* E = (float*)(ws + OFF_E);
#pragma unroll
      for (int i = 0; i < 4; i++)
#pragma unroll
        for (int j = 0; j < 4; j++)
#pragma unroll
          for (int jj = 0; jj < 4; jj++) {
            const int st = i * 16 + (lane >> 4) * 4 + jj;
            const int chunk = half * 128 + wc * 64 + j * 16 + (lane & 15);
            E[(((size_t)g * 256 + chunk) * 64 + st) * 2 + wr] = acc[i][j][jj];
          }
    }
  }
  if (((((int)gridDim.x - 33 - (int)blockIdx.x) % (int)gridDim.x + (int)gridDim.x) % (int)gridDim.x) < 64)
    dep_publish((unsigned*)(ws + OFF_WQ_SSM3 + 512));
  {
    const int lane = get_tid() & 63, wid = get_tid() >> 6, wr = wid >> 1, wc = wid & 1;
    for (int task = gridDim.x - 1 - blockIdx.x; task < 32; task += gridDim.x) {
      const int prob = task >> 3, tm = task & 7;
      const int kv = prob >> 1, g = prob & 1;
      const bf16_t* A = (const bf16_t*)(ws + OFF_KV + (size_t)kv * KV_STRIDE) + (size_t)g * SEQ * 64;
      const bf16_t* Bt = (const bf16_t*)(ws + (kv ? OFF_W1V : OFF_W1K));
      const float* bias = (const float*)(ws + (kv ? OFF_BIASV : OFF_BIASK));
      bf16_t* HID = (bf16_t*)(ws + OFF_HID) + (size_t)prob * 1024 * 128;
      f32x4 acc[4][4];
      gemm_tile_128(A, 1024, 1023, Bt, 2048, 128, 2048, tm * 128, 0, smem, acc);
#pragma unroll
      for (int i = 0; i < 4; i++)
#pragma unroll
        for (int j = 0; j < 4; j++)
#pragma unroll
          for (int jj = 0; jj < 4; jj++) {
            int row = tm * 128 + wr * 64 + i * 16 + (lane >> 4) * 4 + jj;
            int col = wc * 64 + j * 16 + (lane & 15);
            if (row < 1023) HID[(size_t)row * 128 + col] = f2bf(gelu_tanh(acc[i][j][jj] + bias[col]));
          }
      asm volatile("s_waitcnt vmcnt(0)" ::: "memory");
      __syncthreads();
      phase3_task(p, smem, task);
    }
  }
  __syncthreads();
  {
    const int nwin = max((int)gridDim.x >> 1, 1);
    if ((int)blockIdx.x < nwin) {
      for (int bt = blockIdx.x; bt < 512; bt += nwin) {
        const int wt = bt * 4 + (get_tid() >> 6);
        attn_tile_task<1>(p, wt >> 1, wt & 1, (float*)smem);
      }
    }
  }
  {
    unsigned* head = (unsigned*)(p.ws + OFF_WQ_SSM3 + 256);
    volatile int* tick = (volatile int*)(smem + SMEM_BYTES - 32);
    for (;;) {
      __syncthreads();
      if (get_tid() == 0) *tick = (int)__hip_atomic_fetch_add(head, 1u, __ATOMIC_RELAXED, __HIP_MEMORY_SCOPE_AGENT);
      __syncthreads();
      const int item0 = *tick;
      if (item0 >= 32 + 512 + 256 + 224) break;
      if (item0 >= 512 + 256 + 224) {
        dep_wait((unsigned*)(ws + OFF_WQ_SSM3 + 512), min(64u, (unsigned)gridDim.x));
        phase3_task(p, smem, 32 + item0 - (512 + 256 + 224));
        continue;
      }
      if (item0 >= 256 + 224) {
        s5_operator_item(p, smem, item0 - (256 + 224));
        continue;
      }
      const int item = item0;
      if (item < 256) {
        convert_item(p, item);
      } else {
        if (item - 256 < 96) {
          for (int k = 0; k < 4; k++) {
            const int t = (item - 256) * 4 + k;
            if (t < 128) transpose_job_w(p.in[17], 512, 1024, (bf16_t*)(ws + OFF_WGLU), 1024, 2, t, smem);
            else transpose_job_w(p.in[18], 1024, 1024, (bf16_t*)(ws + OFF_WOUT), 1024, 0, t - 128, smem);
          }
        } else {
          const int w = item - 256 - 96, hh = w >> 3, kt = w & 7;
          f32x4 acc[4][4];
          gemm_tile_128((const bf16_t*)(ws + OFF_SUBT) + (size_t)(hh & 1) * 128 * 128, 128, 128, (const bf16_t*)(ws + OFF_WQB) + hh * 128, 2048,
                        1024, 128, 0, kt * 128, smem, acc);
          const int lane = get_tid() & 63, wid = get_tid() >> 6, wr = wid >> 1, wc = wid & 1;
          bf16_t* WP = (bf16_t*)(ws + OFF_WQ) + (size_t)hh * 128 * 1024 + kt * 128;
#pragma unroll
          for (int i = 0; i < 4; i++)
#pragma unroll
            for (int j = 0; j < 4; j++)
#pragma unroll
              for (int jj = 0; jj < 4; jj++)
                WP[(size_t)(wr * 64 + i * 16 + (lane >> 4) * 4 + jj) * 1024 + wc * 64 + j * 16 + (lane & 15)] = f2bf(acc[i][j][jj]);
        }
      }
    }
  }
}

#define LOG2E_F 1.4426950408889634f
#define NEGC (-1e30f)
#define IMP_STRIDE 258
__device__ __forceinline__ bf16x8 ldfrag(const bf16_t* p) { return *(const bf16x8*)p; }
__device__ __forceinline__ bf16x8 pack8(const float (&v)[8]) {
  u32x4 w = {pack2(v[0], v[1]), pack2(v[2], v[3]), pack2(v[4], v[5]), pack2(v[6], v[7])};
  return __builtin_bit_cast(bf16x8, w);
}
__device__ __forceinline__ float ex2(float x) { return __builtin_amdgcn_exp2f(x); }
__device__ __forceinline__ void qk_tile(const bf16x8 (&kf)[4], const bf16x8& q0, const bf16x8& q1, f32x4& sa, f32x4& sb) {
  const f32x4 z = {0.f, 0.f, 0.f, 0.f};
  sa = __builtin_amdgcn_mfma_f32_16x16x32_bf16(kf[0], q0, z, 0, 0, 0);
  sa = __builtin_amdgcn_mfma_f32_16x16x32_bf16(kf[1], q1, sa, 0, 0, 0);
  sb = __builtin_amdgcn_mfma_f32_16x16x32_bf16(kf[2], q0, z, 0, 0, 0);
  sb = __builtin_amdgcn_mfma_f32_16x16x32_bf16(kf[3], q1, sb, 0, 0, 0);
}
__device__ __forceinline__ void load_k(bf16x8 (&kf)[4], const bf16_t* kr) {
  kf[0] = ldfrag(kr);
  kf[1] = ldfrag(kr + 32);
  kf[2] = ldfrag(kr + 256);
  kf[3] = ldfrag(kr + 288);
}
__device__ __forceinline__ void load_v(bf16x8 (&vf)[4], const bf16_t* vr, size_t ldv16) {
  vf[0] = ldfrag(vr);
  vf[1] = ldfrag(vr + ldv16);
  vf[2] = ldfrag(vr + 2 * ldv16);
  vf[3] = ldfrag(vr + 3 * ldv16);
}

template <int MODE>
__device__ __forceinline__ void attn_tile_task(const Params& p, int tt, int g, float* impw) {
  char* ws = p.ws;
  const int lane = get_tid() & 63, col = lane & 15, q = lane >> 4;
  const int t0 = tt * 16, tok = t0 + col;
  const bf16_t* Qp = (const bf16_t*)(ws + OFF_Q) + ((size_t)tok * 8 + g * 4) * 64 + 8 * q;
  const bf16_t* Kb;
  const bf16_t* Vb;
  size_t ldv;
  int kt_lo, kt_hi;
  if (MODE == 0) {
    Kb = (const bf16_t*)(ws + OFF_KC) + (size_t)g * 1024 * 64;
    Vb = (const bf16_t*)(ws + OFF_VC) + (size_t)g * 64 * 1024;
    ldv = 1024;
    kt_lo = 0;
    kt_hi = (t0 + 15 >= 31) ? (((t0 + 15 - 31) >> 4) >> 5) : -1;
  } else {
    Kb = (const bf16_t*)(ws + OFF_KV + 4 * KV_STRIDE) + (size_t)g * SEQ * 64;
    Vb = (const bf16_t*)(ws + OFF_KV + 5 * KV_STRIDE) + (size_t)g * 64 * SEQ;
    ldv = SEQ;
    kt_lo = max(t0 - 511, 0) >> 5;
    kt_hi = (t0 + 15) >> 5;
  }
  const int hi_lim = (MODE == 0) ? ((tok >= 31) ? ((tok - 31) >> 4) : -1) : tok;
  const int lo_lim = (MODE == 0) ? 0 : tok - 511;
  bf16x8 qf[4][2];
#pragma unroll
  for (int h = 0; h < 4; h++) {
    qf[h][0] = ldfrag(Qp + h * 64);
    qf[h][1] = ldfrag(Qp + h * 64 + 32);
  }
  const int mA = 8 * (col >> 2) + (col & 3);
  const bf16_t* Krow = Kb + (size_t)mA * 64 + 8 * q;
  const bf16_t* Vrow = Vb + (size_t)col * ldv + 8 * q;
  const size_t ldv16 = 16 * ldv;
  float mrun[4], lrun[4];
#pragma unroll
  for (int h = 0; h < 4; h++) { mrun[h] = NEGC; lrun[h] = 0.f; }

  const int hi_min = (MODE == 0) ? ((t0 >= 31) ? ((t0 - 31) >> 4) : -1) : t0;
  const int lo_max = (MODE == 0) ? 0 : t0 + 15 - 511;
  auto body1 = [&](const bf16x8 (&kf)[4], int kt, auto masked) __attribute__((always_inline)) {
    constexpr bool MK = decltype(masked)::value;
    const int key0 = kt * 32 + 8 * q;
#pragma unroll
    for (int h = 0; h < 4; h++) {
      f32x4 sa, sb;
      qk_tile(kf, qf[h][0], qf[h][1], sa, sb);
      float s[8];
      bool v[8];
#pragma unroll
      for (int r = 0; r < 4; r++) {
        if (MK) {
          int ka = key0 + r, kb2 = key0 + 4 + r;
          v[r] = (ka <= hi_lim) && (ka >= lo_lim);
          v[4 + r] = (kb2 <= hi_lim) && (kb2 >= lo_lim);
          s[r] = v[r] ? sa[r] * LOG2E_F : NEGC;
          s[4 + r] = v[4 + r] ? sb[r] * LOG2E_F : NEGC;
        } else {
          v[r] = true;
          v[4 + r] = true;
          s[r] = sa[r] * LOG2E_F;
          s[4 + r] = sb[r] * LOG2E_F;
        }
      }
      float tm = fmaxf(fmaxf(fmaxf(s[0], s[1]), fmaxf(s[2], s[3])), fmaxf(fmaxf(s[4], s[5]), fmaxf(s[6], s[7])));
      float mn = fmaxf(mrun[h], tm);
      if (MODE == 0) {
        float e = 0.f;
#pragma unroll
        for (int r = 0; r < 8; r++) e += (!MK || v[r]) ? ex2(s[r] - mn) : 0.f;
        lrun[h] = lrun[h] * ex2(mrun[h] - mn) + e;
      }
      mrun[h] = mn;
    }
  };
  auto run1 = [&](const bf16x8 (&kf)[4], int kt) __attribute__((always_inline)) {
    if (32 * kt + 31 <= hi_min && 32 * kt >= lo_max) body1(kf, kt, std::false_type{});
    else body1(kf, kt, std::true_type{});
  };
  if (kt_lo <= kt_hi) {
    bf16x8 kA[4], kB[4];
    load_k(kA, Krow + (size_t)kt_lo * 2048);
    for (int kt = kt_lo; kt <= kt_hi; kt += 2) {
      if (kt + 1 <= kt_hi) load_k(kB, Krow + (size_t)(kt + 1) * 2048);
      run1(kA, kt);
      if (kt + 1 <= kt_hi) {
        if (kt + 2 <= kt_hi) load_k(kA, Krow + (size_t)(kt + 2) * 2048);
        run1(kB, kt + 1);
      }
    }
  }
  float inv[4];
#pragma unroll
  for (int h = 0; h < 4; h++) {
    float ma = fmaxf(mrun[h], __shfl_xor(mrun[h], 16, 64));
    ma = fmaxf(ma, __shfl_xor(ma, 32, 64));
    if (MODE == 0) {
      float ls = lrun[h] * ex2(mrun[h] - ma);
      ls += __shfl_xor(ls, 16, 64);
      ls += __shfl_xor(ls, 32, 64);
      inv[h] = (ls > 0.f) ? (1.f / ls) : 0.f;
    } else {
      inv[h] = 1.f;
      lrun[h] = 0.f;
    }
    mrun[h] = (MODE == 0) ? ((inv[h] > 0.f) ? ma - __log2f(inv[h]) : 1e30f) : ma;
  }

  f32x4 o[4][4];
#pragma unroll
  for (int h = 0; h < 4; h++)
#pragma unroll
    for (int mt = 0; mt < 4; mt++) o[h][mt] = (f32x4){0.f, 0.f, 0.f, 0.f};
  float carry = 0.f;
  auto body2 = [&](const bf16x8 (&kf)[4], const bf16x8 (&vf)[4], int kt, auto masked) __attribute__((always_inline)) {
    constexpr bool MK = decltype(masked)::value;
    const int key0 = kt * 32 + 8 * q;
    float a4 = 0.f, b4 = 0.f, p3h = 0.f, p7h = 0.f;
#pragma unroll
    for (int h = 0; h < 4; h++) {
      f32x4 sa, sb;
      qk_tile(kf, qf[h][0], qf[h][1], sa, sb);
      float pr[8];
#pragma unroll
      for (int r = 0; r < 4; r++) {
        if (MK) {
          int ka = key0 + r, kb2 = key0 + 4 + r;
          bool va = (ka <= hi_lim) && (ka >= lo_lim);
          bool vb = (kb2 <= hi_lim) && (kb2 >= lo_lim);
          pr[r] = va ? ex2(sa[r] * LOG2E_F - mrun[h]) : 0.f;
          pr[4 + r] = vb ? ex2(sb[r] * LOG2E_F - mrun[h]) : 0.f;
        } else {
          pr[r] = ex2(sa[r] * LOG2E_F - mrun[h]);
          pr[4 + r] = ex2(sb[r] * LOG2E_F - mrun[h]);
        }
      }
      if (MODE == 1) lrun[h] += ((pr[0] + pr[1]) + (pr[2] + pr[3])) + ((pr[4] + pr[5]) + (pr[6] + pr[7]));
      bf16x8 pk = pack8(pr);
#pragma unroll
      for (int mt = 0; mt < 4; mt++) o[h][mt] = __builtin_amdgcn_mfma_f32_16x16x32_bf16(vf[mt], pk, o[h][mt], 0, 0, 0);
      if (MODE == 0) {
        a4 += (pr[0] + pr[1]) + (pr[2] + pr[3]);
        b4 += (pr[4] + pr[5]) + (pr[6] + pr[7]);
        p3h += pr[3];
        p7h += pr[7];
      }
    }
    if (MODE == 0) {
      float rot = __shfl(p7h, (lane + 48) & 63, 64);
      float val = (q == 0) ? carry : rot;
      carry = rot;
      const int m = 8 * kt + 2 * q;
      *(float2*)&impw[col * IMP_STRIDE + m] = make_float2(val + a4, p3h + b4);
    }
  };
  auto run2 = [&](const bf16x8 (&kf)[4], const bf16x8 (&vf)[4], int kt) __attribute__((always_inline)) {
    if (32 * kt + 31 <= hi_min && 32 * kt >= lo_max) body2(kf, vf, kt, std::false_type{});
    else body2(kf, vf, kt, std::true_type{});
  };
  if (kt_lo <= kt_hi) {
    bf16x8 kA[4], kB[4], vA[4], vB[4];
    load_k(kA, Krow + (size_t)kt_lo * 2048);
    load_v(vA, Vrow + (size_t)kt_lo * 32, ldv16);
    for (int kt = kt_lo; kt <= kt_hi; kt += 2) {
      if (kt + 1 <= kt_hi) {
        load_k(kB, Krow + (size_t)(kt + 1) * 2048);
        load_v(vB, Vrow + (size_t)(kt + 1) * 32, ldv16);
      }
      run2(kA, vA, kt);
      if (kt + 1 <= kt_hi) {
        if (kt + 2 <= kt_hi) {
          load_k(kA, Krow + (size_t)(kt + 2) * 2048);
          load_v(vA, Vrow + (size_t)(kt + 2) * 32, ldv16);
        }
        run2(kB, vB, kt + 1);
      }
    }
  }
  if (MODE == 1) {
#pragma unroll
    for (int h = 0; h < 4; h++) {
      float ls = lrun[h];
      ls += __shfl_xor(ls, 16, 64);
      ls += __shfl_xor(ls, 32, 64);
      const float iv = (ls > 0.f) ? (1.f / ls) : 0.f;
#pragma unroll
      for (int mt = 0; mt < 4; mt++) o[h][mt] = o[h][mt] * iv;
    }
  }
  {
    bf16_t* dst = (bf16_t*)(ws + OFF_Z + (MODE == 0 ? 0ull : 16 * MB)) + (size_t)tok * 512 + g * 256 + 4 * q;
#pragma unroll
    for (int h = 0; h < 4; h++)
#pragma unroll
      for (int mt = 0; mt < 4; mt++) {
        uint2 w;
        w.x = pack2(o[h][mt][0], o[h][mt][1]);
        w.y = pack2(o[h][mt][2], o[h][mt][3]);
        *(uint2*)(dst + h * 64 + mt * 16) = w;
      }
  }
  if (MODE == 0) {
    wave_lds_sync();
    unsigned char* SEL = (unsigned char*)(ws + OFF_HID);
#pragma unroll 1
    for (int rd = 0; rd < 4; rd++) {
      const int tsel = 4 * rd + q;
      const int tk = t0 + tsel;
      const int cur = tk >> 6;
      unsigned kk[16];
#pragma unroll
      for (int c = 0; c < 16; c++) {
        const int m = col + 16 * c;
        unsigned bits = __float_as_uint(impw[tsel * IMP_STRIDE + m]);
        kk[c] = (m >= 1 && m <= cur - 2) ? ((bits & 0xFFFFFF00u) | (unsigned)(255 - m)) : 0u;
      }
      unsigned myidx = 0;
#pragma unroll 1
      for (int r = 0; r < 13; r++) {
        unsigned w = kk[0];
#pragma unroll
        for (int c = 1; c < 16; c++) w = max(w, kk[c]);
        w = max(w, (unsigned)__builtin_amdgcn_update_dpp(0u, w, 0x128, 0xF, 0xF, false));
        w = max(w, (unsigned)__builtin_amdgcn_update_dpp(0u, w, 0x124, 0xF, 0xF, false));
        w = max(w, (unsigned)__builtin_amdgcn_update_dpp(0u, w, 0x122, 0xF, 0xF, false));
        w = max(w, (unsigned)__builtin_amdgcn_update_dpp(0u, w, 0x121, 0xF, 0xF, false));
        if (col == r) myidx = 255u - (w & 255u);
#pragma unroll
        for (int c = 0; c < 16; c++) kk[c] = (kk[c] == w) ? 0u : kk[c];
      }
      if (cur >= 16) {
        unsigned char* sp = SEL + ((size_t)tk * 2 + g) * 16;
        if (col < 13) sp[3 + col] = (unsigned char)myidx;
        if (col == 13) sp[0] = 0;
        if (col == 14) sp[1] = (unsigned char)(cur - 1);
        if (col == 15) sp[2] = (unsigned char)cur;
      }
    }
    wave_lds_sync();
  }
}

__device__ __forceinline__ long mk64(unsigned lo, unsigned hi) { return (long)(((unsigned long long)hi << 32) | (unsigned long long)lo); }
__device__ __forceinline__ f32x4 mfma8(long a, long b, f32x4 c) { return __builtin_amdgcn_mfma_f32_16x16x32_fp8_fp8(a, b, c, 0, 0, 0); }
__device__ __forceinline__ void attn_sel_task(const Params& p, int t0, int g, char* wlds) {
  char* ws = p.ws;
  const int lane = get_tid() & 63, col = lane & 15, q = lane >> 4;
  const int tok = col >> 2, hd = col & 3, t = t0 + tok;
  long q0, q1;
  {
    const bf16_t* Qp = (const bf16_t*)(ws + OFF_Q) + ((size_t)t * 8 + g * 4 + hd) * 64 + 16 * q;
    uint4 qa = *(const uint4*)Qp, qb = *(const uint4*)(Qp + 8);
    const float sc = 64.f;
    int w0 = __builtin_amdgcn_cvt_pk_fp8_f32(bflo(qa.x) * sc, bfhi(qa.x) * sc, 0, false);
    w0 = __builtin_amdgcn_cvt_pk_fp8_f32(bflo(qa.y) * sc, bfhi(qa.y) * sc, w0, true);
    int w1 = __builtin_amdgcn_cvt_pk_fp8_f32(bflo(qa.z) * sc, bfhi(qa.z) * sc, 0, false);
    w1 = __builtin_amdgcn_cvt_pk_fp8_f32(bflo(qa.w) * sc, bfhi(qa.w) * sc, w1, true);
    int w2 = __builtin_amdgcn_cvt_pk_fp8_f32(bflo(qb.x) * sc, bfhi(qb.x) * sc, 0, false);
    w2 = __builtin_amdgcn_cvt_pk_fp8_f32(bflo(qb.y) * sc, bfhi(qb.y) * sc, w2, true);
    int w3 = __builtin_amdgcn_cvt_pk_fp8_f32(bflo(qb.z) * sc, bfhi(qb.z) * sc, 0, false);
    w3 = __builtin_amdgcn_cvt_pk_fp8_f32(bflo(qb.w) * sc, bfhi(qb.w) * sc, w3, true);
    q0 = mk64((unsigned)w0, (unsigned)w1);
    q1 = mk64((unsigned)w2, (unsigned)w3);
  }
  const unsigned char* Krow = (const unsigned char*)(ws + OFF_KV + 2 * KV_STRIDE) + (size_t)g * SEQ * 64 +
                              (size_t)(16 * (col >> 2) + (col & 3)) * 64 + 16 * q;
  const unsigned char* Vrow = (const unsigned char*)(ws + OFF_KV + 3 * KV_STRIDE) + (size_t)g * 256 * 4096 + (size_t)col * 64 + 16 * q;
  const int cur = t0 >> 6;
  LAS unsigned* flags = (LAS unsigned*)wlds;
  LAS unsigned* list = (LAS unsigned*)(wlds + 256);
  wave_lds_sync();
  flags[lane] = 0u;
  wave_lds_sync();
  {
    const int tk = lane >> 4, e = lane & 15;
    int id = -1;
    if (cur >= 16) id = (int)((const unsigned char*)(ws + OFF_HID))[((size_t)(t0 + tk) * 2 + g) * 16 + e];
    else if (e <= cur) id = e;
    if (id >= 0) (void)__hip_atomic_fetch_or(&flags[id >> 2], (1u << tk) << (8 * (id & 3)), __ATOMIC_RELAXED, __HIP_MEMORY_SCOPE_WORKGROUP);
  }
  wave_lds_sync();
  int n = 0;
  {
    const unsigned fw = flags[lane];
    const unsigned long long lt = (1ull << lane) - 1ull;
#pragma unroll
    for (int qq = 0; qq < 4; qq++) {
      const unsigned m = (fw >> (8 * qq)) & 15u;
      const unsigned long long bal = __ballot(m != 0u);
      if (m != 0u) list[n + __popcll(bal & lt)] = (unsigned)(4 * lane + qq) | (m << 8);
      n += __popcll(bal);
    }
  }
  wave_lds_sync();
  auto load_blk = [&](u32x4 (&kf)[4], u32x4 (&vf)[4], int blk) __attribute__((always_inline)) {
    const unsigned char* kr = Krow + (size_t)blk * 4096;
    kf[0] = *(const u32x4*)(kr);
    kf[1] = *(const u32x4*)(kr + 256);
    kf[2] = *(const u32x4*)(kr + 512);
    kf[3] = *(const u32x4*)(kr + 768);
    const unsigned char* vr = Vrow + (size_t)blk * 4096;
    vf[0] = *(const u32x4*)(vr);
    vf[1] = *(const u32x4*)(vr + 1024);
    vf[2] = *(const u32x4*)(vr + 2048);
    vf[3] = *(const u32x4*)(vr + 3072);
  };
  float mrun = -1.0e4f, lrun = 0.f;
  f32x4 o[4];
#pragma unroll
  for (int mt = 0; mt < 4; mt++) o[mt] = (f32x4){0.f, 0.f, 0.f, 0.f};
  const float SSC = LOG2E_F * (1.f / 512.f);
  auto body = [&](const u32x4 (&kf)[4], const u32x4 (&vf)[4], unsigned ent) __attribute__((always_inline)) {
    const int blk = (int)(ent & 255u);
    const unsigned msk = ent >> 8;
    const bool valid = ((msk >> tok) & 1u) != 0u;
    const f32x4 z = {0.f, 0.f, 0.f, 0.f};
    f32x4 sa0 = mfma8(mk64(kf[0].x, kf[0].y), q0, z);
    sa0 = mfma8(mk64(kf[0].z, kf[0].w), q1, sa0);
    f32x4 sb0 = mfma8(mk64(kf[1].x, kf[1].y), q0, z);
    sb0 = mfma8(mk64(kf[1].z, kf[1].w), q1, sb0);
    f32x4 sa1 = mfma8(mk64(kf[2].x, kf[2].y), q0, z);
    sa1 = mfma8(mk64(kf[2].z, kf[2].w), q1, sa1);
    f32x4 sb1 = mfma8(mk64(kf[3].x, kf[3].y), q0, z);
    sb1 = mfma8(mk64(kf[3].z, kf[3].w), q1, sb1);
    float s[16];
#pragma unroll
    for (int r = 0; r < 4; r++) {
      s[r] = sa0[r];
      s[4 + r] = sb0[r];
      s[8 + r] = sa1[r];
      s[12 + r] = sb1[r];
    }
    if (blk == cur) {
      const int key0 = blk * 64 + 16 * q;
      const int lim = valid ? t : -1;
#pragma unroll
      for (int r = 0; r < 8; r++) {
        s[r] = (key0 + r <= lim) ? s[r] : -1e30f;
        s[8 + r] = (key0 + 8 + r <= lim) ? s[8 + r] : -1e30f;
      }
    }
    float tm = fmaxf(fmaxf(fmaxf(s[0], s[1]), fmaxf(s[2], s[3])), fmaxf(fmaxf(s[4], s[5]), fmaxf(s[6], s[7])));
    float tm2 = fmaxf(fmaxf(fmaxf(s[8], s[9]), fmaxf(s[10], s[11])), fmaxf(fmaxf(s[12], s[13]), fmaxf(s[14], s[15])));
    tm = fmaxf(tm, tm2);
    tm = valid ? tm : -1e30f;
    tm *= SSC;
    if (!__all(tm <= mrun + 1.0f)) {
      tm = fmaxf(tm, __shfl_xor(tm, 16, 64));
      tm = fmaxf(tm, __shfl_xor(tm, 32, 64));
      const float mn = fmaxf(mrun, tm);
      const float alpha = ex2(mrun - mn);
      mrun = mn;
      lrun *= alpha;
#pragma unroll
      for (int mt = 0; mt < 4; mt++) {
        o[mt][0] *= alpha; o[mt][1] *= alpha; o[mt][2] *= alpha; o[mt][3] *= alpha;
      }
    }
    float pr[16];
    const float mb = valid ? 7.f - mrun : -1e30f;
#pragma unroll
    for (int r = 0; r < 16; r++) pr[r] = ex2(__builtin_fmaf(s[r], SSC, mb));
    lrun += ((pr[0] + pr[1]) + (pr[2] + pr[3])) + ((pr[4] + pr[5]) + (pr[6] + pr[7])) +
            ((pr[8] + pr[9]) + (pr[10] + pr[11])) + ((pr[12] + pr[13]) + (pr[14] + pr[15]));
    int w0 = __builtin_amdgcn_cvt_pk_fp8_f32(pr[0], pr[1], 0, false);
    w0 = __builtin_amdgcn_cvt_pk_fp8_f32(pr[2], pr[3], w0, true);
    int w1 = __builtin_amdgcn_cvt_pk_fp8_f32(pr[4], pr[5], 0, false);
    w1 = __builtin_amdgcn_cvt_pk_fp8_f32(pr[6], pr[7], w1, true);
    int w2 = __builtin_amdgcn_cvt_pk_fp8_f32(pr[8], pr[9], 0, false);
    w2 = __builtin_amdgcn_cvt_pk_fp8_f32(pr[10], pr[11], w2, true);
    int w3 = __builtin_amdgcn_cvt_pk_fp8_f32(pr[12], pr[13], 0, false);
    w3 = __builtin_amdgcn_cvt_pk_fp8_f32(pr[14], pr[15], w3, true);
    const long pk0 = mk64((unsigned)w0, (unsigned)w1), pk1 = mk64((unsigned)w2, (unsigned)w3);
#pragma unroll
    for (int mt = 0; mt < 4; mt++) {
      o[mt] = mfma8(mk64(vf[mt].x, vf[mt].y), pk0, o[mt]);
      o[mt] = mfma8(mk64(vf[mt].z, vf[mt].w), pk1, o[mt]);
    }
  };
  {
    u32x4 kA[4], vA[4], kB[4], vB[4];
    unsigned entA = (unsigned)__builtin_amdgcn_readfirstlane((int)list[0]), entB = 0u;
    load_blk(kA, vA, (int)(entA & 255u));
#pragma unroll 1
    for (int b = 0; b < n; b += 2) {
      if (b + 1 < n) {
        entB = (unsigned)__builtin_amdgcn_readfirstlane((int)list[b + 1]);
        load_blk(kB, vB, (int)(entB & 255u));
      }
      body(kA, vA, entA);
      if (b + 1 < n) {
        if (b + 2 < n) {
          entA = (unsigned)__builtin_amdgcn_readfirstlane((int)list[b + 2]);
          load_blk(kA, vA, (int)(entA & 255u));
        }
        body(kB, vB, entB);
      }
    }
  }
  {
    float ls = lrun;
    ls += __shfl_xor(ls, 16, 64);
    ls += __shfl_xor(ls, 32, 64);
    const float inv = (ls > 0.f) ? (0.125f / ls) : 0.f;
#pragma unroll
    for (int mt = 0; mt < 4; mt++) {
      o[mt][0] *= inv; o[mt][1] *= inv; o[mt][2] *= inv; o[mt][3] *= inv;
    }
  }
  {
    const float* gt = (const float*)(ws + OFF_GATES) + (size_t)t * 24 + (g * 4 + hd) * 3;
    const float gc = gt[0], gs = gt[1], gw = gt[2];
    const size_t off = (size_t)t * 512 + (g * 4 + hd) * 64 + 4 * q;
    const bf16_t* OC = (const bf16_t*)(ws + OFF_Z) + off;
    const bf16_t* OW = (const bf16_t*)(ws + OFF_Z + 16 * MB) + off;
    bf16_t* MIX = (bf16_t*)(ws + OFF_MIX) + (size_t)t * 1024 + (g * 4 + hd) * 64 + 4 * q;
#pragma unroll
    for (int mt = 0; mt < 4; mt++) {
      uint2 c2 = *(const uint2*)(OC + mt * 16);
      uint2 w2 = *(const uint2*)(OW + mt * 16);
      float r0 = gc * bflo(c2.x) + gs * o[mt][0] + gw * bflo(w2.x);
      float r1 = gc * bfhi(c2.x) + gs * o[mt][1] + gw * bfhi(w2.x);
      float r2 = gc * bflo(c2.y) + gs * o[mt][2] + gw * bflo(w2.y);
      float r3 = gc * bfhi(c2.y) + gs * o[mt][3] + gw * bfhi(w2.y);
      uint2 wv;
      wv.x = pack2(r0, r1);
      wv.y = pack2(r2, r3);
      *(uint2*)(MIX + mt * 16) = wv;
    }
  }
}
__device__ __forceinline__ void phase4(const Params& p, char* smem) {
  const int wid = get_tid() >> 6;
  float* impw = (float*)(smem + wid * (16 * IMP_STRIDE * 4));
  {
    const int half = max((int)gridDim.x >> 1, 1);
    if ((int)blockIdx.x < half) {
      for (int pw = blockIdx.x * 4 + wid; pw < 1024; pw += half * 4) {
        const int g = pw & 1, k = pw >> 1;
        attn_tile_task<0>(p, 1023 - k, g, impw);
        attn_tile_task<0>(p, k, g, impw);
      }
    }
  }
  unsigned* head = (unsigned*)(p.ws + OFF_WQ_SSM3);
  volatile int* tick = (volatile int*)(smem + SMEM_BYTES - 32);
  for (;;) {
    __syncthreads();
    if (get_tid() == 0) *tick = (int)__hip_atomic_fetch_add(head, 1u, __ATOMIC_RELAXED, __HIP_MEMORY_SCOPE_AGENT);
    __syncthreads();
    const int task = *tick;
    if (task >= 512) break;
    s5_output_tile(p, smem, task);
  }
}
__device__ __forceinline__ unsigned hw_xcc_id() { return (unsigned)__builtin_amdgcn_s_getreg((3 << 11) | 20) & 0x7u; }
#define OFF_WQ_CNT (244 * MB + 16384)
__device__ __forceinline__ void phase4b(const Params& p, char* smem) {
  const int wid = get_tid() >> 6;
  unsigned* qcnt = (unsigned*)(p.ws + OFF_WQ_CNT);
  volatile int* tick = (volatile int*)(smem + SMEM_BYTES - 32);
  const unsigned x = hw_xcc_id();
  for (int k = 0; k < 8; k++) {
    const int part = (int)((x + k) & 7u);
    const int g = part & 1, quarter = part >> 1;
    for (;;) {
      __syncthreads();
      if (get_tid() == 0) *tick = (int)__hip_atomic_fetch_add(&qcnt[part * 64], 1u, __ATOMIC_RELAXED, __HIP_MEMORY_SCOPE_AGENT);
      __syncthreads();
      const int bt = *tick;
      if (bt >= 256) break;
      const int t0 = quarter * 4096 + 16 * (255 - bt) + 4 * wid;
      attn_sel_task(p, t0, g, smem + wid * 512);
    }
  }
}

__device__ __forceinline__ void phase5(const Params& p, char* smem) {
  char* ws = p.ws;
  const int lane = get_tid() & 63, wid = get_tid() >> 6, wr = wid >> 1, wc = wid & 1;
  const bf16_t* YG = (const bf16_t*)(ws + OFF_YG);
  const bf16_t* W = (const bf16_t*)(ws + OFF_WGLU);
  bf16_t* MIX = (bf16_t*)(ws + OFF_MIX);
  unsigned* head = (unsigned*)(ws + OFF_WQ_SSM3 + 768);
  volatile int* tick = (volatile int*)(smem + SMEM_BYTES - 32);
  for (;;) {
    __syncthreads();
    if (get_tid() == 0) *tick = (int)__hip_atomic_fetch_add(head, 1u, __ATOMIC_RELAXED, __HIP_MEMORY_SCOPE_AGENT);
    __syncthreads();
    const int tile = *tick;
    if (tile >= 128 * 8) break;
    const int tm = tile >> 3, tn = tile & 7;
    f32x4 acc[4][4];
    gemm_tile_128<0, true, 1>(YG, 512, SEQ, W, 512, 1024, 512, tm * 128, tn * 128, smem, acc);
    const int b64 = tn * 2 + wc;
    {
      const float* t = stage_acc(acc, smem);
      const int rs = lane >> 2, c8 = (lane & 3) * 8;
#pragma unroll
      for (int it = 0; it < 4; it++) {
        const int r = it * 16 + rs;
        const float* tr = t + r * EPI_LD;
        float4 a0 = *(const float4*)(tr + c8), a1 = *(const float4*)(tr + c8 + 4);
        float4 b0 = *(const float4*)(tr + 32 + c8), b1 = *(const float4*)(tr + 32 + c8 + 4);
        uint4 w;
        w.x = pack2(a0.x * sigmoid_f(b0.x), a0.y * sigmoid_f(b0.y));
        w.y = pack2(a0.z * sigmoid_f(b0.z), a0.w * sigmoid_f(b0.w));
        w.z = pack2(a1.x * sigmoid_f(b1.x), a1.y * sigmoid_f(b1.y));
        w.w = pack2(a1.z * sigmoid_f(b1.z), a1.w * sigmoid_f(b1.w));
        *(uint4*)(MIX + (size_t)(tm * 128 + wr * 64 + r) * 1024 + 512 + 32 * b64 + c8) = w;
      }
      __syncthreads();
    }
  }
}

__device__ __forceinline__ void phase6(const Params& p, char* smem) {
  char* ws = p.ws;
  const int lane = get_tid() & 63, wid = get_tid() >> 6, wr = wid >> 1, wc = wid & 1;
  const bf16_t* MIX = (const bf16_t*)(ws + OFF_MIX);
  const bf16_t* W = (const bf16_t*)(ws + OFF_WOUT);
  const float* x = p.in[0];
  const bool xmap = ((int)gridDim.x == 512);
  for (int it = 0;; it++) {
    int tm, tn;
    if (xmap) {
      if (it >= 2) break;
      const int idx = ((int)blockIdx.x >> 3) * 2 + it;
      tm = ((int)blockIdx.x & 7) + 8 * (idx >> 3);
      tn = idx & 7;
    } else {
      const int tile = (int)blockIdx.x + it * (int)gridDim.x;
      if (tile >= 128 * 8) break;
      tm = tile >> 3;
      tn = tile & 7;
    }
    f32x4 acc[4][4];
    gemm_tile_128(MIX, 1024, SEQ, W, 1024, 1024, 1024, tm * 128, tn * 128, smem, acc);
    {
      const int rs = lane >> 4, c4 = (lane & 15) * 4;
      float4 xr[16];
#pragma unroll
      for (int it = 0; it < 16; it++)
        xr[it] = *(const float4*)(x + (size_t)(tm * 128 + wr * 64 + it * 4 + rs) * 1024 + tn * 128 + wc * 64 + c4);
      const float* t = stage_acc(acc, smem);
      bf16_t* XW = (bf16_t*)(ws + OFF_Z);
      float* SSQ = (float*)(ws + OFF_SSQ);
#pragma unroll
      for (int it = 0; it < 16; it++) {
        const int r = it * 4 + rs;
        const size_t row = (size_t)(tm * 128 + wr * 64 + r);
        const size_t o = row * 1024 + tn * 128 + wc * 64 + c4;
        float4 a = *(const float4*)(t + r * EPI_LD + c4);
        const float4 xv = xr[it];
        const float4 hv = make_float4(xv.x + a.x, xv.y + a.y, xv.z + a.z, xv.w + a.w);
        uint2 w;
        w.x = pack2(hv.x, hv.y);
        w.y = pack2(hv.z, hv.w);
        *(uint2*)(XW + o) = w;
        float ss = (hv.x * hv.x + hv.y * hv.y) + (hv.z * hv.z + hv.w * hv.w);
        ss += __uint_as_float((unsigned)__builtin_amdgcn_update_dpp(0u, __float_as_uint(ss), 0x128, 0xF, 0xF, false));
        ss += __uint_as_float((unsigned)__builtin_amdgcn_update_dpp(0u, __float_as_uint(ss), 0x124, 0xF, 0xF, false));
        ss += __uint_as_float((unsigned)__builtin_amdgcn_update_dpp(0u, __float_as_uint(ss), 0x122, 0xF, 0xF, false));
        ss += __uint_as_float((unsigned)__builtin_amdgcn_update_dpp(0u, __float_as_uint(ss), 0x121, 0xF, 0xF, false));
        if ((lane & 15) == 0) SSQ[(size_t)(tn * 2 + wc) * SEQ + row] = ss;
      }
      __syncthreads();
    }
  }
}

#define OFF_TOPV (112 * MB)
#define OFF_TOPI (OFF_TOPV + 16 * MB)
__device__ __forceinline__ void phase8(const Params& p, char* smem) {
  char* ws = p.ws;
  bf16_t(*sQ)[136] = (bf16_t(*)[136])smem;
  float(*sS)[132] = (float(*)[132])smem;
  for (int tile = blockIdx.x; tile < 128 * 16; tile += gridDim.x) {
    const int tm = tile >> 4, tn = tile & 15;
    const int h = tn >> 1, hf = tn & 1;
    float* rsq = (float*)(smem + 73728);
    if (get_tid() < 128) {
      const float* pp = (const float*)(ws + OFF_SSQ) + (size_t)(tm * 128 + get_tid());
      float sp[16];
#pragma unroll
      for (int i = 0; i < 16; i++) sp[i] = pp[(size_t)i * SEQ];
      const float ss = (((sp[0] + sp[1]) + (sp[2] + sp[3])) + ((sp[4] + sp[5]) + (sp[6] + sp[7]))) +
                       (((sp[8] + sp[9]) + (sp[10] + sp[11])) + ((sp[12] + sp[13]) + (sp[14] + sp[15])));
      rsq[get_tid()] = rsqrtf(ss * (1.f / 1024.f) + 1e-6f);
    }
    f32x4 acc[4][4];
    gemm_tile_128((const bf16_t*)(ws + OFF_Z), 1024, SEQ, (const bf16_t*)(ws + OFF_WQ), 1024, 2048, 1024, tm * 128, tn * 128, smem, acc);
    const int lane = get_tid() & 63, wid = get_tid() >> 6, wr = wid >> 1, wc = wid & 1;
    const int col = lane & 15, q = lane >> 4;
    float* TOPV = (float*)(ws + OFF_TOPV);
    unsigned char* TOPI = (unsigned char*)(ws + OFF_TOPI);
#pragma unroll
    for (int i = 0; i < 4; i++) {
      const float4 rv = *(const float4*)&rsq[wr * 64 + i * 16 + q * 4];
      const float rr[4] = {rv.x, rv.y, rv.z, rv.w};
#pragma unroll
      for (int j = 0; j < 4; j++)
#pragma unroll
        for (int jj = 0; jj < 4; jj++) sS[wr * 64 + i * 16 + q * 4 + jj][wc * 64 + j * 16 + col] = acc[i][j][jj] * rr[jj];
    }
    __syncthreads();
#pragma unroll 1
    for (int ps = 0; ps < 8; ps++) {
      const int row = wid * 32 + ps * 4 + q;
      unsigned kk[8];
#pragma unroll
      for (int c = 0; c < 8; c++) {
        const int k = col + 16 * c;
        unsigned bits = __float_as_uint(sS[row][k]);
        unsigned u = bits ^ ((unsigned)((int)bits >> 31) | 0x80000000u);
        kk[c] = (u & 0xFFFFFF80u) | (unsigned)(127 - k);
      }
#define CSWAP(a, b) { unsigned hi_ = max(kk[a], kk[b]), lo_ = min(kk[a], kk[b]); kk[a] = hi_; kk[b] = lo_; }
      CSWAP(0, 1) CSWAP(2, 3) CSWAP(4, 5) CSWAP(6, 7)
      CSWAP(0, 2) CSWAP(1, 3) CSWAP(4, 6) CSWAP(5, 7)
      CSWAP(1, 2) CSWAP(5, 6)
      CSWAP(0, 4) CSWAP(1, 5) CSWAP(2, 6) CSWAP(3, 7)
      CSWAP(2, 4) CSWAP(3, 5)
      CSWAP(1, 2) CSWAP(3, 4) CSWAP(5, 6)
#undef CSWAP
      unsigned mine = 0;
#pragma unroll 1
      for (int r = 0; r < 16; r++) {
        unsigned w = kk[0];
        w = max(w, (unsigned)__builtin_amdgcn_update_dpp(0u, w, 0x128, 0xF, 0xF, false));
        w = max(w, (unsigned)__builtin_amdgcn_update_dpp(0u, w, 0x124, 0xF, 0xF, false));
        w = max(w, (unsigned)__builtin_amdgcn_update_dpp(0u, w, 0x122, 0xF, 0xF, false));
        w = max(w, (unsigned)__builtin_amdgcn_update_dpp(0u, w, 0x121, 0xF, 0xF, false));
        if (col == r) mine = w;
        const bool pop = (kk[0] == w);
        kk[0] = pop ? kk[1] : kk[0];
        kk[1] = pop ? kk[2] : kk[1];
        kk[2] = pop ? kk[3] : kk[2];
        kk[3] = pop ? kk[4] : kk[3];
        kk[4] = pop ? kk[5] : kk[4];
        kk[5] = pop ? kk[6] : kk[5];
        kk[6] = pop ? kk[7] : kk[6];
        kk[7] = pop ? 0u : kk[7];
      }
      const int idx = 127 - (int)(mine & 127u);
      const float val = sS[row][idx];
      const size_t o = ((size_t)tn * SEQ + (size_t)(tm * 128 + row)) * 16 + col;
      TOPV[o] = val;
      TOPI[o] = (unsigned char)idx;
    }
    __syncthreads();
  }
}

__device__ const unsigned char STAIR_TAB[64] = {0, 1, 2, 3, 4, 5, 6, 7, 8, 9, 10, 11, 12, 13, 14, 15, 16, 17, 18, 19, 20, 21, 22, 23, 32, 33, 34, 35, 36, 48, 49, 50, 51, 64, 65, 66, 80, 81, 96, 97, 112, 113, 128, 144, 160, 176, 192, 208, 224, 240, 0, 0, 0, 0, 0, 0, 0, 0, 0, 0, 0, 0, 0, 0};
__device__ __forceinline__ void wave_sort_desc(float& v, int& c, int lane) {
#pragma unroll
  for (int k = 2; k <= 64; k <<= 1) {
#pragma unroll
    for (int j = k >> 1; j > 0; j >>= 1) {
      float ov = __shfl_xor(v, j, 64);
      int oc = __shfl_xor(c, j, 64);
      bool other_first = (ov > v) || (ov == v && oc < c);
      bool lower = (lane & j) == 0;
      bool asc = (lane & k) == 0;
      bool take_first = (lower == asc);
      bool take_other = (take_first == other_first);
      v = take_other ? ov : v;
      c = take_other ? oc : c;
    }
  }
}

__device__ __forceinline__ unsigned xor_lane_u32(unsigned v, int j, int lane) {
  if (j == 1) return (unsigned)__builtin_amdgcn_update_dpp(0u, v, 0xB1, 0xF, 0xF, false);
  if (j == 2) return (unsigned)__builtin_amdgcn_update_dpp(0u, v, 0x4E, 0xF, 0xF, false);
  if (j == 8) return (unsigned)__builtin_amdgcn_update_dpp(0u, v, 0x128, 0xF, 0xF, false);
  if (j == 4) {
    const unsigned up = (unsigned)__builtin_amdgcn_update_dpp(0u, v, 0x12C, 0xF, 0xF, false);
    const unsigned dn = (unsigned)__builtin_amdgcn_update_dpp(0u, v, 0x124, 0xF, 0xF, false);
    return (lane & 4) ? dn : up;
  }
  return (unsigned)__shfl_xor((int)v, j, 64);
}
__device__ __forceinline__ void phase9(const Params& p, char* smem) {
  char* ws = p.ws;
  const int tid = get_tid(), lane = tid & 63, wid = tid >> 6;
  int* pe = (int*)(smem + wid * 2560);
  float* pg = (float*)(smem + wid * 2560 + 512);
  float* tvl = (float*)(smem + wid * 2560 + 1024);
  unsigned char* til = (unsigned char*)(smem + wid * 2560 + 2048);
  const float* TOPV = (const float*)(ws + OFF_TOPV);
  const unsigned char* TOPI = (const unsigned char*)(ws + OFF_TOPI);
  const bf16_t* XN = (const bf16_t*)(ws + OFF_Z);
  const unsigned char* UT8 = (const unsigned char*)(ws + OFF_UT);
  const unsigned char* VT8 = UT8 + 16 * MB;
  const float* fng = p.in[25];
  const int st = STAIR_TAB[lane];
  const int sti = st >> 4, stj = st & 15;
  float4 ncv = make_float4(0.f, 0.f, 0.f, 0.f);
  unsigned nci = 0u;
  {
    const int t0 = blockIdx.x * 4 + wid;
    if (t0 < SEQ) {
      const int l4 = 4 * (get_tid() & 63);
      const size_t co = ((size_t)(l4 >> 4) * SEQ + (size_t)t0) * 16 + (l4 & 15);
      ncv = *(const float4*)((const float*)(ws + OFF_TOPV) + co);
      nci = *(const unsigned*)((const unsigned char*)(ws + OFF_TOPI) + co);
    }
  }
  for (int t = blockIdx.x * 4 + wid; t < SEQ; t += gridDim.x * 4) {
    wave_lds_sync();
    {
      const int l4 = 4 * (get_tid() & 63);
      *(float4*)(tvl + l4) = ncv;
      *(unsigned*)(til + l4) = nci;
    }
    uint4 xraw[4];
    float ssp = 0.f;
    {
      const bf16_t* xp = XN + (size_t)t * 1024 + 32 * (get_tid() & 31);
#pragma unroll
      for (int i = 0; i < 4; i++) xraw[i] = *(const uint4*)(xp + 8 * i);
      if ((get_tid() & 63) < 16) ssp = ((const float*)(ws + OFF_SSQ))[(size_t)(get_tid() & 63) * SEQ + t];
    }
    wave_lds_sync();
    const int half = lane >> 5, ck = lane & 31;
    const unsigned char* UT6 = (const unsigned char*)(ws + OFF_UT) + 16 * ck;
    const unsigned char* VT4 = (const unsigned char*)(ws + OFF_UT) + 768 + 16 * ck;
#define NSL 2
    auto rows_load = [&](uint2 (&ur)[NSL][3], uint4 (&vr)[NSL], float (&gate)[NSL], int pp) __attribute__((always_inline)) {
#pragma unroll
      for (int k = 0; k < NSL; k++) {
        const int pi = min(pp + 2 * k + half, 127);
        const int e = pe[pi];
        gate[k] = (pp + 2 * k + half < 128) ? pg[pi] : 0.f;
        const unsigned char* up = UT6 + (size_t)e * 1280;
        const uint4 ua = *(const uint4*)up;
        ur[k][0] = make_uint2(ua.x, ua.y); ur[k][1] = make_uint2(ua.z, ua.w); ur[k][2] = *(const uint2*)(up + 512 - 8 * ck);
        vr[k] = *(const uint4*)(VT4 + (size_t)e * 1280);
      }
    };
    uint2 urA[NSL][3];
    uint4 vrA[NSL];
    float gA[NSL];
#pragma unroll 1
    for (int h = 0; h < 8; h++) {
      const float cvx = tvl[h * 32 + sti] + tvl[h * 32 + 16 + stj];
      const unsigned bits = __float_as_uint(cvx);
      unsigned key = ((bits ^ ((unsigned)((int)bits >> 31) | 0x80000000u)) & 0xFFFFFF00u) | (unsigned)(255 - st);
      if (lane >= 50) key = 0u;
#pragma unroll
      for (int k = 2; k <= 64; k <<= 1) {
#pragma unroll
        for (int j = k >> 1; j > 0; j >>= 1) {
          const unsigned other = xor_lane_u32(key, j, lane);
          const bool take_max = (((lane & j) == 0) == ((lane & k) == 0));
          key = take_max ? max(key, other) : min(key, other);
        }
      }
      const int cc = 255 - (int)(key & 255u);
      const float cv = tvl[h * 32 + ((cc >> 4) & 15)] + tvl[h * 32 + 16 + (cc & 15)];
      const float mx = __uint_as_float((unsigned)__builtin_amdgcn_readfirstlane((int)__float_as_uint(cv)));
      float ex = (lane < 16) ? expf(cv - mx) : 0.f;
      float sm = wave_sum(ex);
      if (lane < 16) {
        const int e = (int)til[h * 32 + ((cc >> 4) & 15)] * 128 + (int)til[h * 32 + 16 + (cc & 15)];
        pe[h * 16 + lane] = e;
        pg[h * 16 + lane] = ex / sm;
      }
      if (h == 0) {
        wave_lds_sync();
        rows_load(urA, vrA, gA, 0);
      }
    }
    wave_lds_sync();
    {
      float xs[32];
      {
        float xn[32];
#pragma unroll
        for (int i = 0; i < 4; i++) {
          const uint4 a = xraw[i];
          xn[8 * i + 0] = bflo(a.x); xn[8 * i + 1] = bfhi(a.x); xn[8 * i + 2] = bflo(a.y); xn[8 * i + 3] = bfhi(a.y);
          xn[8 * i + 4] = bflo(a.z); xn[8 * i + 5] = bfhi(a.z); xn[8 * i + 6] = bflo(a.w); xn[8 * i + 7] = bfhi(a.w);
        }
        const float rstd = rsqrtf(wave_sum(ssp) * (1.f / 1024.f) + 1e-6f);
#pragma unroll
        for (int i = 0; i < 8; i++) {
          const float4 g4 = *(const float4*)(p.in[19] + 32 * ck + 4 * i);
          xn[4 * i + 0] *= g4.x * rstd; xn[4 * i + 1] *= g4.y * rstd; xn[4 * i + 2] *= g4.z * rstd; xn[4 * i + 3] *= g4.w * rstd;
        }
#pragma unroll
        for (int j = 0; j < 32; j++) xs[j] = xn[FP6_COL(j)];
      }
      typedef float f32x2 __attribute__((ext_vector_type(2)));
      f32x2 oacc2[16];
#pragma unroll
      for (int j = 0; j < 16; j++) oacc2[j] = (f32x2){0.f, 0.f};
      auto rows_use = [&](const uint2 (&ur)[NSL][3], const uint4 (&vr)[NSL], const float (&gate)[NSL]) __attribute__((always_inline)) {
        float hid[NSL];
#pragma unroll
        for (int k = 0; k < NSL; k++) {
          v6u_t w = {ur[k][0].x, ur[k][0].y, ur[k][1].x, ur[k][1].y, ur[k][2].x, ur[k][2].y};
          v32f_t du = __builtin_amdgcn_cvt_scalef32_pk32_f32_fp6(w, 1.0f);
          float s0 = 0.f, s1 = 0.f;
#pragma unroll
          for (int j = 0; j < 32; j += 2) { s0 += xs[j] * du[j]; s1 += xs[j + 1] * du[j + 1]; }
          hid[k] = s0 + s1;
        }
#pragma unroll
        for (int k = 0; k < NSL; k++) {
          float h = hid[k];
          h += __uint_as_float((unsigned)__builtin_amdgcn_update_dpp(0u, __float_as_uint(h), 0x128, 0xF, 0xF, false));
          h += __uint_as_float((unsigned)__builtin_amdgcn_update_dpp(0u, __float_as_uint(h), 0x124, 0xF, 0xF, false));
          h += __uint_as_float((unsigned)__builtin_amdgcn_update_dpp(0u, __float_as_uint(h), 0x122, 0xF, 0xF, false));
          h += __uint_as_float((unsigned)__builtin_amdgcn_update_dpp(0u, __float_as_uint(h), 0x121, 0xF, 0xF, false));
          hid[k] = h + __shfl_xor(h, 16, 64);
        }
#pragma unroll
        for (int k = 0; k < NSL; k++) {
          const float act = gelu_tanh(hid[k] * (1.f / 64.f)) * gate[k];
          typedef float f32x2 __attribute__((ext_vector_type(2)));
          const unsigned wv[4] = {vr[k].x, vr[k].y, vr[k].z, vr[k].w};
          const f32x2 a2 = {act, act};
#pragma unroll
          for (int d = 0; d < 4; d++) {
            oacc2[4 * d + 0] = __builtin_elementwise_fma(a2, __builtin_amdgcn_cvt_scalef32_pk_f32_fp4(wv[d], 1.0f, 0), oacc2[4 * d + 0]);
            oacc2[4 * d + 1] = __builtin_elementwise_fma(a2, __builtin_amdgcn_cvt_scalef32_pk_f32_fp4(wv[d], 1.0f, 1), oacc2[4 * d + 1]);
            oacc2[4 * d + 2] = __builtin_elementwise_fma(a2, __builtin_amdgcn_cvt_scalef32_pk_f32_fp4(wv[d], 1.0f, 2), oacc2[4 * d + 2]);
            oacc2[4 * d + 3] = __builtin_elementwise_fma(a2, __builtin_amdgcn_cvt_scalef32_pk_f32_fp4(wv[d], 1.0f, 3), oacc2[4 * d + 3]);
          }
        }
      };
      {
        uint2 urB[NSL][3];
        uint4 vrB[NSL];
        float gB[NSL];
        {
          const int tn_ = t + (int)gridDim.x * 4;
          if (tn_ < SEQ) {
            const int l4 = 4 * (get_tid() & 63);
            const size_t co = ((size_t)(l4 >> 4) * SEQ + (size_t)tn_) * 16 + (l4 & 15);
            ncv = *(const float4*)((const float*)(ws + OFF_TOPV) + co);
            nci = *(const unsigned*)((const unsigned char*)(ws + OFF_TOPI) + co);
          }
        }
#pragma unroll 1
        for (int pp = 0; pp < 128; pp += 4 * NSL) {
          rows_load(urB, vrB, gB, pp + 2 * NSL);
          rows_use(urA, vrA, gA);
          if (pp + 4 * NSL < 128) rows_load(urA, vrA, gA, pp + 4 * NSL);
          rows_use(urB, vrB, gB);
        }
      }
#undef NSL
      float oacc[32];
#pragma unroll
      for (int j = 0; j < 32; j++) {
        const float v = oacc2[j >> 1][j & 1];
        oacc[j] = v + __shfl_xor(v, 32, 64);
      }
      float hv[32];
      float ss = 0.f;
      float* hrow = p.out + (size_t)t * 1024 + 32 * ck;
      if (half == 0) {
        float on[32];
#pragma unroll
        for (int j = 0; j < 32; j++) on[j] = oacc[j] * 0.25f;
#pragma unroll
        for (int i = 0; i < 4; i++) {
          const uint4 a = *(const uint4*)(XN + (size_t)t * 1024 + 32 * ck + 8 * i);
          hv[8 * i + 0] = bflo(a.x) + on[8 * i + 0]; hv[8 * i + 1] = bfhi(a.x) + on[8 * i + 1];
          hv[8 * i + 2] = bflo(a.y) + on[8 * i + 2]; hv[8 * i + 3] = bfhi(a.y) + on[8 * i + 3];
          hv[8 * i + 4] = bflo(a.z) + on[8 * i + 4]; hv[8 * i + 5] = bfhi(a.z) + on[8 * i + 5];
          hv[8 * i + 6] = bflo(a.w) + on[8 * i + 6]; hv[8 * i + 7] = bfhi(a.w) + on[8 * i + 7];
        }
#pragma unroll
        for (int j = 0; j < 32; j++) ss += hv[j] * hv[j];
      } else {
#pragma unroll
        for (int j = 0; j < 32; j++) hv[j] = 0.f;
      }
      ss = wave_sum(ss);
      const float inv = rsqrtf(ss * (1.f / 1024.f) + 1e-6f);
      if (half == 0) {
#pragma unroll
        for (int i = 0; i < 8; i++) {
          float4 gg = *(const float4*)(fng + 32 * ck + 4 * i);
          *(float4*)(hrow + 4 * i) = make_float4(hv[4 * i] * inv * gg.x, hv[4 * i + 1] * inv * gg.y, hv[4 * i + 2] * inv * gg.z, hv[4 * i + 3] * inv * gg.w);
        }
      }
    }
  }
}

#define XB_TMO      128
#define XB_XCNT(j)  (256  + 64 * (j))
#define XB_XSUB(j)  (1280 + 64 * (j))
#define XB_XGEN(j)  (2304 + 64 * (j))
#define XB_TOP      3328
#define XB_TOPGEN   3392
#define XCD_BAR_WORDS 3456
#define XB_SPIN_CAP (1u << 22)
__device__ __forceinline__ unsigned xb_ld(unsigned* p) { return __hip_atomic_load(p, __ATOMIC_RELAXED, __HIP_MEMORY_SCOPE_AGENT); }
__device__ __forceinline__ unsigned xb_add(unsigned* p, unsigned v) { return __hip_atomic_fetch_add(p, v, __ATOMIC_RELAXED, __HIP_MEMORY_SCOPE_AGENT); }
__device__ __forceinline__ unsigned xb_xcc_id() { return (unsigned)__builtin_amdgcn_s_getreg((3 << 11) | 20) & 0xFu; }
#define XB_SPIN(cond, bar) do { unsigned _sp = 0; while (cond) { __builtin_amdgcn_s_sleep(1); \
    if ((++_sp & 255u) == 0u) { if (xb_ld(&(bar)[XB_TMO])) break; if (_sp > XB_SPIN_CAP) { atomicAdd(&(bar)[XB_TMO], 1u); break; } } } } while (0)
struct XcdBarrier { unsigned* bar; unsigned x; volatile LAS unsigned* st; };
__device__ __forceinline__ XcdBarrier xcd_barrier_post(unsigned* bar, volatile LAS unsigned* st) {
  XcdBarrier b; b.bar = bar; b.x = xb_xcc_id(); b.st = st;
  if (threadIdx.x == 0) (void)xb_add(&bar[XB_XCNT(b.x)], 1u);
  return b;
}
__device__ __forceinline__ void xcd_barrier_complete(unsigned* bar, unsigned x, unsigned& nloc, unsigned& nx) {
  const unsigned G = gridDim.x * gridDim.y * gridDim.z;
  unsigned sum, cnt, mine, sp = 0u;
  for (;;) {
    sum = 0u; cnt = 0u; mine = 0u;
#pragma unroll
    for (unsigned j = 0; j < 16; ++j) { const unsigned c = xb_ld(&bar[XB_XCNT(j)]); sum += c; cnt += (c > 0u) ? 1u : 0u; mine = (j == x) ? c : mine; }
    if (sum == G) break;
    __builtin_amdgcn_s_sleep(1);
    if ((++sp & 255u) == 0u) { if (xb_ld(&bar[XB_TMO])) break; if (sp > XB_SPIN_CAP) { atomicAdd(&bar[XB_TMO], 1u); break; } }
  }
  nloc = mine > 0u ? mine : 1u; nx = cnt > 0u ? cnt : 1u;
}
__device__ __forceinline__ void xcd_barrier(const XcdBarrier& b) {
  asm volatile("s_waitcnt vmcnt(0)" ::: "memory");
  __syncthreads();
  if (threadIdx.x == 0) {
    unsigned* bar = b.bar;
    __builtin_amdgcn_s_waitcnt(0);
    unsigned nloc = b.st[0], nx = b.st[1];
    if (nloc == 0u) { xcd_barrier_complete(bar, b.x, nloc, nx); b.st[0] = nloc; b.st[1] = nx; }
    const unsigned old = xb_add(&bar[XB_XSUB(b.x)], 1u);
    const unsigned gen = old / nloc;
    if (old + 1u == (gen + 1u) * nloc) {
      __builtin_amdgcn_fence(__ATOMIC_RELEASE, "agent");
      asm volatile("s_waitcnt vmcnt(0)" ::: "memory");
      const unsigned og = xb_add(&bar[XB_TOP], 1u);
      const unsigned tg = og / nx;
      if (og + 1u == (tg + 1u) * nx) xb_add(&bar[XB_TOPGEN], 1u);
      else XB_SPIN(xb_ld(&bar[XB_TOPGEN]) == tg, bar);
      __builtin_amdgcn_fence(__ATOMIC_ACQUIRE, "agent");
      xb_add(&bar[XB_XGEN(b.x)], 1u);
      asm volatile("s_waitcnt vmcnt(0)" ::: "memory");
    } else {
      XB_SPIN(xb_ld(&bar[XB_XGEN(b.x)]) == gen, bar);
      __builtin_amdgcn_fence(__ATOMIC_ACQUIRE, "agent");
      asm volatile("s_waitcnt vmcnt(0)" ::: "memory");
    }
  }
  __syncthreads();
}

#define OFF_BAR (244 * MB)
__global__ void __launch_bounds__(256, 2) k_mega(Params p) {
  __shared__ __attribute__((aligned(16))) char smem[SMEM_BYTES];
  cg::grid_group grid = cg::this_grid();
  volatile LAS unsigned* xbw = (volatile LAS unsigned*)(smem + SMEM_BYTES - 16);
  if (threadIdx.x == 0) { xbw[0] = 0u; xbw[1] = 0u; xbw[2] = 0u; xbw[3] = 0u; }
  __syncthreads();
  XcdBarrier xb = xcd_barrier_post((unsigned*)(p.ws + OFF_BAR), xbw);
  if (p.ws == nullptr) grid.sync();
  phase0(p, smem); xcd_barrier(xb);
  phase1(p, smem); xcd_barrier(xb);
  phase2(p, smem); xcd_barrier(xb);
  phase4(p, smem); xcd_barrier(xb);
  phase4b(p, smem);
  __syncthreads();
  phase5(p, smem); xcd_barrier(xb);
  phase6(p, smem); xcd_barrier(xb);
  phase8(p, smem); xcd_barrier(xb);
  phase9(p, smem);
}

extern "C" void kernel_launch(void* const* d_in, const int* in_sizes, int n_in, void* d_out, int out_size,
                              void* d_ws, size_t ws_size, hipStream_t stream) {
  Params p{};
  for (int i = 0; i < 26; i++) p.in[i] = (const float*)d_in[i];
  p.out = (float*)d_out;
  p.ws = (char*)d_ws;
  static int grid_blocks = 0;
  if (!grid_blocks) {
    int dev = 0, cus = 0, per_cu = 0;
    (void)hipGetDevice(&dev);
    (void)hipDeviceGetAttribute(&cus, hipDeviceAttributeMultiprocessorCount, dev);
    (void)hipOccupancyMaxActiveBlocksPerMultiprocessor(&per_cu, k_mega, 256, 0);
    if (per_cu > 2) per_cu = 2;
    if (per_cu < 1) per_cu = 1;
    grid_blocks = cus * per_cu;
  }
  (void)hipMemsetAsync((char*)d_ws + OFF_BAR, 0, 32768, stream);
  void* args[] = {&p};
  hipError_t e = hipLaunchCooperativeKernel((void*)k_mega, dim3(grid_blocks), dim3(256), args, 0, stream);
  if (e != hipSuccess) fprintf(stderr, "cooperative launch failed: %s (grid %d)\n", hipGetErrorString(e), grid_blocks);
}
```
